# Optimizing an MI355X kernel written in HIP

```python
import math
import jax, jax.numpy as jnp
from jax import lax
import numpy as np


D_MODEL = 2048
BATCH = 8
SEQ = 2048
DEPTH = 2

CHUNK = 64
Q_BLOCK = 128
GROUP_W = 512
D_MIX = 4 * GROUP_W
EPS = 1e-6
NEG = -1e30

GMLP_BLOCK = 128
A_GROUPS = 4
A_GDIM = GROUP_W // A_GROUPS

B_HEADS = 8
B_HDIM = GROUP_W // B_HEADS
IDX_HEADS = 8
IDX_DIM = 64
TOPK_MAX = 256
T5_BUCKETS = 32
T5_MAX_DIST = 128

C_HEADS = 4
C_NOPE = 128
C_ROPE = 64
C_VDIM = GROUP_W // C_HEADS
C_QK = C_NOPE + C_ROPE
Q_LORA = 384
KV_LORA = 128
ROPE_BASE = 10000.0

D_HEADS = 8
D_HDIM = GROUP_W // D_HEADS
D_LEFT_CHUNKS = 8
D_BAND = (D_LEFT_CHUNKS + 1) * CHUNK
REL_CLIP = 128

IN_SIZES = (
    GROUP_W, GROUP_W, GROUP_W,
    GROUP_W, B_HDIM, B_HDIM, IDX_HEADS * IDX_DIM, IDX_DIM, IDX_HEADS, GROUP_W,
    Q_LORA, KV_LORA, C_ROPE, GROUP_W,
    GROUP_W, GROUP_W, GROUP_W, GROUP_W,
)
IN_COLS = sum(IN_SIZES)

kernel_name = "chunk_causal_hybrid_head_groups"


def rms_norm(x, g):
    xf = x.astype(jnp.float32)
    y = xf * lax.rsqrt(jnp.mean(xf * xf, axis=-1, keepdims=True) + EPS)
    return (y * g.astype(jnp.float32)).astype(x.dtype)


def softmax_f32(s):
    return jax.nn.softmax(s.astype(jnp.float32), axis=-1)


def split_cols(h, sizes):
    out, o = [], 0
    for n in sizes:
        out.append(h[..., o:o + n])
        o += n
    return out


def to_blocks(a, size):
    b, s = a.shape[0], a.shape[1]
    return a.reshape(b, s // size, size, *a.shape[2:]).swapaxes(0, 1)


def from_blocks(o):
    nb, b, size = o.shape[0], o.shape[1], o.shape[2]
    return o.swapaxes(0, 1).reshape(b, nb * size, -1)


def gmlp_mixer(u, v, v_gain, w_s, b_s):
    bsz, s, _ = u.shape
    nb = s // GMLP_BLOCK
    u = jax.nn.gelu(u)
    v = rms_norm(jax.nn.gelu(v), v_gain)
    pos_chunk = jnp.arange(GMLP_BLOCK) // CHUNK
    mask = pos_chunk[None, :] <= pos_chunk[:, None]
    w = jnp.where(mask[None], w_s, 0.0)
    vb = v.reshape(bsz, nb, GMLP_BLOCK, A_GROUPS, A_GDIM)
    sg = jnp.einsum('gij,bnjgc->bnigc', w, vb) + b_s.T[None, None, :, :, None]
    return u * sg.reshape(bsz, s, GROUP_W)


def t5_bucket(rel):
    nb = T5_BUCKETS // 2
    max_exact = nb // 2
    ret = jnp.where(rel > 0, nb, 0)
    n = jnp.abs(rel)
    nf = jnp.maximum(n, 1).astype(jnp.float32)
    large = max_exact + (jnp.log(nf / max_exact) / math.log(T5_MAX_DIST / max_exact)
                         * (nb - max_exact)).astype(jnp.int32)
    large = jnp.minimum(large, nb - 1)
    return ret + jnp.where(n < max_exact, n, large)


def dsa_mixer(q, k, v, iq, ik, iw, q_gain, k_gain, t5_bias):
    bsz, s, _ = q.shape
    topk = min(TOPK_MAX, s // 4)
    q = rms_norm(q.reshape(bsz, s, B_HEADS, B_HDIM), q_gain)
    k = rms_norm(k, k_gain)
    iq = iq.reshape(bsz, s, IDX_HEADS, IDX_DIM)
    key_chunk = jnp.arange(s) // CHUNK
    starts = jnp.arange(s // Q_BLOCK) * Q_BLOCK

    def block(args):
        qb, iqb, iwb, start = args
        qpos = start + jnp.arange(Q_BLOCK)
        qchunk = qpos // CHUNK
        adm = key_chunk[None, :] <= qchunk[:, None]
        logits = jnp.einsum('bthd,bsd->bths', iqb, ik).astype(jnp.float32) * (IDX_DIM ** -0.5)
        score = jnp.einsum('bth,bths->bts', iwb.astype(jnp.float32) * (IDX_HEADS ** -0.5),
                           jax.nn.relu(logits))
        score = jnp.where(adm[None], score, -jnp.inf)
        _, idx = lax.top_k(score, topk)
        valid = (idx // CHUNK) <= qchunk[None, :, None]
        ks = jax.vmap(lambda a, i: a[i])(k, idx)
        vs = jax.vmap(lambda a, i: a[i])(v, idx)
        sc = jnp.einsum('bthd,btkd->bhtk', qb, ks).astype(jnp.float32) * (B_HDIM ** -0.5)
        bias = t5_bias[t5_bucket(idx - qpos[None, :, None])]
        sc = jnp.where(valid[:, None], sc + bias.transpose(0, 3, 1, 2).astype(jnp.float32), NEG)
        p = softmax_f32(sc).astype(vs.dtype)
        return jnp.einsum('bhtk,btkd->bthd', p, vs)

    out = lax.map(block, (to_blocks(q, Q_BLOCK), to_blocks(iq, Q_BLOCK),
                          to_blocks(iw, Q_BLOCK), starts))
    return from_blocks(out)


def rope_tables(s):
    inv = ROPE_BASE ** (-jnp.arange(0, C_ROPE, 2, dtype=jnp.float32) / C_ROPE)
    ang = jnp.arange(s, dtype=jnp.float32)[:, None] * inv[None, :]
    return jnp.cos(ang), jnp.sin(ang)


def apply_rope(x, cos, sin):
    x1, x2 = jnp.split(x.astype(jnp.float32), 2, axis=-1)
    c, s_ = cos[None, :, None], sin[None, :, None]
    return jnp.concatenate([x1 * c - x2 * s_, x1 * s_ + x2 * c], axis=-1).astype(x.dtype)


def mla_mixer(cq, ckv, krope, qa_gain, kva_gain, w_qb, w_kvb, q_gain, k_gain):
    bsz, s, _ = cq.shape
    cq = rms_norm(cq, qa_gain)
    ckv = rms_norm(ckv, kva_gain)
    q = (cq @ w_qb).reshape(bsz, s, C_HEADS, C_QK)
    kv = (ckv @ w_kvb).reshape(bsz, s, C_HEADS, C_NOPE + C_VDIM)
    k_nope, v = kv[..., :C_NOPE], kv[..., C_NOPE:]
    k = jnp.concatenate([k_nope, jnp.broadcast_to(krope[:, :, None], (bsz, s, C_HEADS, C_ROPE))], axis=-1)
    q = rms_norm(q, q_gain)
    k = rms_norm(k, k_gain)
    cos, sin = rope_tables(s)
    q = jnp.concatenate([q[..., :C_NOPE], apply_rope(q[..., C_NOPE:], cos, sin)], axis=-1)
    k = jnp.concatenate([k[..., :C_NOPE], apply_rope(k[..., C_NOPE:], cos, sin)], axis=-1)
    key_chunk = jnp.arange(s) // CHUNK
    starts = jnp.arange(s // Q_BLOCK) * Q_BLOCK

    def block(args):
        qb, start = args
        qchunk = (start + jnp.arange(Q_BLOCK)) // CHUNK
        mask = key_chunk[None, :] <= qchunk[:, None]
        sc = jnp.einsum('bthd,bshd->bhts', qb, k).astype(jnp.float32) * (C_QK ** -0.5)
        sc = jnp.where(mask[None, None], sc, NEG)
        p = softmax_f32(sc).astype(v.dtype)
        return jnp.einsum('bhts,bshd->bthd', p, v)

    out = lax.map(block, (to_blocks(q, Q_BLOCK), starts))
    return from_blocks(out)


def band_mixer(q, k, v, q_gain, k_gain, rel_bias):
    bsz, s, _ = q.shape
    nc = s // CHUNK
    q = rms_norm(q.reshape(bsz, s, D_HEADS, D_HDIM), q_gain)
    k = rms_norm(k.reshape(bsz, s, D_HEADS, D_HDIM), k_gain)
    v = v.reshape(bsz, s, D_HEADS, D_HDIM)
    pad = D_LEFT_CHUNKS * CHUNK
    kp = jnp.pad(k, ((0, 0), (pad, 0), (0, 0), (0, 0)))
    vp = jnp.pad(v, ((0, 0), (pad, 0), (0, 0), (0, 0)))
    i = jnp.arange(CHUNK)
    j = jnp.arange(D_BAND)
    dist = (pad + i)[:, None] - j[None, :]
    bias = rel_bias[jnp.clip(dist, -REL_CLIP, REL_CLIP) + REL_CLIP].transpose(2, 0, 1)
    bias = bias.astype(jnp.float32)

    def chunk(args):
        qb, c = args
        kb = lax.dynamic_slice_in_dim(kp, c * CHUNK, D_BAND, axis=1)
        vb = lax.dynamic_slice_in_dim(vp, c * CHUNK, D_BAND, axis=1)
        valid = j >= (D_LEFT_CHUNKS - c) * CHUNK
        sc = jnp.einsum('bthd,bshd->bhts', qb, kb).astype(jnp.float32) * (D_HDIM ** -0.5) + bias[None]
        sc = jnp.where(valid[None, None, None], sc, NEG)
        p = softmax_f32(sc).astype(vb.dtype)
        return jnp.einsum('bhts,bshd->bthd', p, vb)

    out = lax.map(chunk, (to_blocks(q, CHUNK), jnp.arange(nc)))
    return from_blocks(out)


def setup_inputs(seed: int = 0) -> dict:
    key = jax.random.key(seed)
    ks = jax.random.split(key, 19)

    def nrm(k, shape, scale):
        return scale * jax.random.normal(k, shape, jnp.float32)

    def gain(k, shape):
        return 1.0 + 0.05 * jax.random.normal(k, shape, jnp.float32)

    return {
        "x": nrm(ks[0], (BATCH, SEQ, D_MODEL), 1.0),
        "t5_bias": nrm(ks[1], (T5_BUCKETS, B_HEADS), 0.5),
        "norm_g": gain(ks[2], (DEPTH, D_MODEL)),
        "w_in": nrm(ks[3], (DEPTH, D_MODEL, IN_COLS), D_MODEL ** -0.5),
        "a_v_gain": gain(ks[4], (DEPTH, GROUP_W)),
        "a_ws": nrm(ks[5], (DEPTH, A_GROUPS, GMLP_BLOCK, GMLP_BLOCK), GMLP_BLOCK ** -0.5),
        "a_bs": 1.0 + nrm(ks[6], (DEPTH, A_GROUPS, GMLP_BLOCK), 0.1),
        "b_q_gain": gain(ks[7], (DEPTH, B_HDIM)),
        "b_k_gain": gain(ks[8], (DEPTH, B_HDIM)),
        "c_qa_gain": gain(ks[9], (DEPTH, Q_LORA)),
        "c_kva_gain": gain(ks[10], (DEPTH, KV_LORA)),
        "c_w_qb": nrm(ks[11], (DEPTH, Q_LORA, C_HEADS * C_QK), Q_LORA ** -0.5),
        "c_w_kvb": nrm(ks[12], (DEPTH, KV_LORA, C_HEADS * (C_NOPE + C_VDIM)), KV_LORA ** -0.5),
        "c_q_gain": gain(ks[13], (DEPTH, C_QK)),
        "c_k_gain": gain(ks[14], (DEPTH, C_QK)),
        "d_q_gain": gain(ks[15], (DEPTH, D_HDIM)),
        "d_k_gain": gain(ks[16], (DEPTH, D_HDIM)),
        "d_rel_bias": nrm(ks[17], (DEPTH, 2 * REL_CLIP + 1, D_HEADS), 0.5),
        "w_out": nrm(ks[18], (DEPTH, D_MIX, D_MODEL), D_MIX ** -0.5),
    }


def reference(x, t5_bias, norm_g, w_in, a_v_gain, a_ws, a_bs, b_q_gain, b_k_gain,
              c_qa_gain, c_kva_gain, c_w_qb, c_w_kvb, c_q_gain, c_k_gain,
              d_q_gain, d_k_gain, d_rel_bias, w_out):
    for l in range(DEPTH):
        h = rms_norm(x, norm_g[l]) @ w_in[l]
        (a_u, a_v, a_z,
         b_q, b_k, b_v, b_iq, b_ik, b_iw, b_z,
         c_q, c_kv, c_kr, c_z,
         d_q, d_k, d_v, d_z) = split_cols(h, IN_SIZES)
        y_a = gmlp_mixer(a_u, a_v, a_v_gain[l], a_ws[l], a_bs[l]) * jax.nn.silu(a_z)
        y_b = dsa_mixer(b_q, b_k, b_v, b_iq, b_ik, b_iw, b_q_gain[l], b_k_gain[l], t5_bias) * jax.nn.silu(b_z)
        y_c = mla_mixer(c_q, c_kv, c_kr, c_qa_gain[l], c_kva_gain[l], c_w_qb[l], c_w_kvb[l],
                        c_q_gain[l], c_k_gain[l]) * jax.nn.silu(c_z)
        y_d = band_mixer(d_q, d_k, d_v, d_q_gain[l], d_k_gain[l], d_rel_bias[l]) * jax.nn.silu(d_z)
        x = x + jnp.concatenate([y_a, y_b, y_c, y_d], axis=-1) @ w_out[l]
    return x
```

```cpp
#include <hip/hip_runtime.h>
#include <hip/hip_cooperative_groups.h>
#include <cstdio>
#include <cstdint>
namespace cg = cooperative_groups;

#define G_ALIGN true
#define G_SP2 true
#define DI __device__ __forceinline__
#define LAS __attribute__((address_space(3)))
typedef __bf16 bf16;
typedef __bf16 bf16x8 __attribute__((ext_vector_type(8)));
typedef __bf16 bf16x4 __attribute__((ext_vector_type(4)));
typedef float f32x4 __attribute__((ext_vector_type(4)));
typedef float f32x8 __attribute__((ext_vector_type(8)));
typedef float f32x16 __attribute__((ext_vector_type(16)));
typedef unsigned u32x4 __attribute__((ext_vector_type(4)));
typedef unsigned u32x2 __attribute__((ext_vector_type(2)));

constexpr int T = 16384, S = 2048, NBATCH = 8, DM = 2048, INC = 6408;
constexpr int LDH = 4864;
constexpr int H_AU = 0, H_AZ = 512, H_BQ = 1024, H_BIQ = 1536, H_BZ = 2048, H_CZ = 2560, H_DQ = 3072, H_DK = 3584, H_DZ = 4096,
              H_BK = 4608, H_BIK = 4672, H_CKR = 4736, H_BIW = 4800;
constexpr int VT_AV = 0, VT_DV = 512, VT_BV = 1024;
constexpr float EPS = 1e-6f, LOG2E = 1.4426950408889634f;
constexpr float SCALE_64 = 0.125f * LOG2E;
constexpr float SCALE_192 = 0.07216878364870322f * LOG2E;
constexpr float C_IW = 0.04419417382415922f;
constexpr int SCLD = 2052;
constexpr int LDS_MISC = 16 * SCLD * 4;
constexpr size_t LDS_BYTES = LDS_MISC + 256;

constexpr size_t MiB = 1048576;
constexpr size_t OFF_U1 = 0;
constexpr size_t OFF_U2 = OFF_U1 + 116 * MiB;
constexpr size_t OFF_U3 = OFF_U2 + 78 * (MiB / 4);
constexpr size_t OFF_H = OFF_U3 + 80 * MiB;
constexpr size_t OFF_VT = OFF_H + (size_t)T * LDH * 2;
constexpr size_t OFF_QC = OFF_VT + (size_t)1280 * T * 2;
constexpr size_t OFF_KC = OFF_QC + (size_t)T * 768 * 2;
constexpr size_t OFF_VCT = OFF_KC + (size_t)T * 768 * 2;
constexpr size_t OFF_MASK = OFF_VCT + (size_t)512 * T * 2;
constexpr size_t OFF_STATS = OFF_MASK + (size_t)T * 64 * 4;
constexpr size_t OFF_SSV = OFF_STATS + (size_t)T * 2 * 4;
constexpr size_t OFF_WA = OFF_SSV + (size_t)T * 4;
constexpr size_t OFF_COS = OFF_WA + 2 * 4 * 128 * 128 * 2;
constexpr size_t OFF_SIN = OFF_COS + 2048 * 32 * 4;
constexpr size_t OFF_T5 = OFF_SIN + 2048 * 32 * 4;
constexpr size_t OFF_DT = OFF_T5 + 8 * 2112 * 4;
constexpr size_t OFF_CTL = OFF_DT + 2 * 8 * 264 * 4;
constexpr size_t CTL_BYTES = 16384;
constexpr size_t OFF_STATK = OFF_CTL + CTL_BYTES;
constexpr size_t OFF_STATL = OFF_STATK + (size_t)2 * T * 4 * 4;
constexpr size_t OFF_STATX = OFF_STATL + (size_t)2 * T * 2 * 4;
constexpr size_t OFF_STATQ = OFF_STATX + (size_t)2 * T * 4;
constexpr size_t WS_NEED = OFF_STATQ + (size_t)2 * T * 4 * 4;

struct Params {
    const float* x; const float* t5_bias; const float* norm_g; const float* w_in; const float* a_v_gain; const float* a_ws; const float* a_bs;
    const float* b_q_gain; const float* b_k_gain; const float* c_qa_gain; const float* c_kva_gain; const float* c_w_qb; const float* c_w_kvb;
    const float* c_q_gain; const float* c_k_gain; const float* d_q_gain; const float* d_k_gain; const float* d_rel_bias; const float* w_out;
    float* out; unsigned char* ws;
};

DI int lane_id() { int t; asm volatile("v_mbcnt_lo_u32_b32 %0, -1, 0\n\tv_mbcnt_hi_u32_b32 %0, -1, %0" : "=v"(t)); return t; }
DI int opaque_tid(int wv) { return (wv << 6) | lane_id(); }
DI float fexp2(float x) { return __builtin_amdgcn_exp2f(x); }
DI float frcp(float x) { return __builtin_amdgcn_rcpf(x); }
DI float frsq(float x) { return __builtin_amdgcn_rsqf(x); }
DI float gelu_t(float x) { const float a = 0.7978845608028654f * (x + 0.044715f * x * x * x); return x * frcp(1.f + fexp2(-2.f * LOG2E * a)); }
DI float silu_f(float z) { return z * frcp(1.f + fexp2(-LOG2E * z)); }
DI bf16x8 cvt8(const float (&v)[8]) { f32x8 t; for (int j = 0; j < 8; ++j) t[j] = v[j]; return __builtin_convertvector(t, bf16x8); }
DI float shx(float v, int m) { return __shfl_xor(v, m); }
template <int CTRL> DI float dppf(float v) { return __int_as_float(__builtin_amdgcn_update_dpp(0, __float_as_int(v), CTRL, 0xF, 0xF, true)); }
#define DPP_XOR1 0xB1
#define DPP_XOR2 0x4E
#define DPP_XOR8 0x128
DI float dpp_xor4(float v) {
    int r = __builtin_amdgcn_update_dpp(0, __float_as_int(v), 0x104, 0xF, 0x5, false);
    r = __builtin_amdgcn_update_dpp(r, __float_as_int(v), 0x114, 0xF, 0xA, false);
    return __int_as_float(r); }
DI float sum8(float s) { s += dppf<DPP_XOR1>(s); s += dppf<DPP_XOR2>(s); s += dpp_xor4(s); return s; }
DI float xrow_sum(float x) { auto r = __builtin_amdgcn_permlane16_swap(__float_as_uint(x), __float_as_uint(x), false, false); return __uint_as_float(r[0]) + __uint_as_float(r[1]); }
DI float xhalf_max(float x) { auto r = __builtin_amdgcn_permlane32_swap(__float_as_uint(x), __float_as_uint(x), false, false); return fmaxf(__uint_as_float(r[0]), __uint_as_float(r[1])); }
DI float xhalf_sum(float x) { auto r = __builtin_amdgcn_permlane32_swap(__float_as_uint(x), __float_as_uint(x), false, false); return __uint_as_float(r[0]) + __uint_as_float(r[1]); }
DI float relu_i(float x) { const int b = __float_as_int(x); return __int_as_float(b > 0 ? b : 0); }
DI int crow(int reg, int h) { return (reg & 3) + 8 * (reg >> 2) + 4 * h; }
#define MFMA32(a, b, c) __builtin_amdgcn_mfma_f32_32x32x16_bf16((a), (b), (c), 0, 0, 0)
#define MFMA16(a, b, c) __builtin_amdgcn_mfma_f32_16x16x32_bf16((a), (b), (c), 0, 0, 0)


#define XB_TMO      128
#define XB_XCNT(j)  (256  + 64 * (j))
#define XB_XSUB(j)  (1280 + 64 * (j))
#define XB_XGEN(j)  (2304 + 64 * (j))
#define XB_TOP      3328
#define XB_TOPGEN   3392
#define XCD_BAR_WORDS 3456
#define XB_CTR(j)   (3520 + 64 * (j))
#define XB_SPIN_CAP (1u << 18)
DI unsigned xb_ld(unsigned* p)              { return __hip_atomic_load(p, __ATOMIC_RELAXED, __HIP_MEMORY_SCOPE_AGENT); }
DI unsigned xb_add(unsigned* p, unsigned v) { return __hip_atomic_fetch_add(p, v, __ATOMIC_RELAXED, __HIP_MEMORY_SCOPE_AGENT); }
DI unsigned xb_xcc_id() { return (unsigned)__builtin_amdgcn_s_getreg((3 << 11) | 20) & 0xFu; }
#define XB_SPIN(cond, bar) do { unsigned _sp = 0; while (cond) { __builtin_amdgcn_s_sleep(1); \
    if ((++_sp & 255u) == 0u) { if (xb_ld(&(bar)[XB_TMO])) break; if (_sp > XB_SPIN_CAP) { atomicAdd(&(bar)[XB_TMO], 1u); break; } } } } while (0)
struct XcdBarrier { unsigned* bar; unsigned x; volatile LAS unsigned* st; };
DI XcdBarrier xcd_barrier_post(unsigned* bar, volatile LAS unsigned* st, bool leader) {
    XcdBarrier b; b.bar = bar; b.x = xb_xcc_id(); b.st = st;
    if (leader) (void)xb_add(&bar[XB_XCNT(b.x)], 1u);
    return b;
}
DI void xcd_barrier_complete(unsigned* bar, unsigned x, unsigned& nloc, unsigned& nx) {
    const unsigned G = gridDim.x * gridDim.y * gridDim.z;
    unsigned sum, cnt, mine, sp = 0u;
    for (;;) {
        sum = 0u; cnt = 0u; mine = 0u;
#pragma unroll
        for (unsigned j = 0; j < 16; ++j) { const unsigned c = xb_ld(&bar[XB_XCNT(j)]); sum += c; cnt += (c > 0u) ? 1u : 0u; mine = (j == x) ? c : mine; }
        if (sum == G) break;
        __builtin_amdgcn_s_sleep(1);
        if ((++sp & 255u) == 0u) { if (xb_ld(&bar[XB_TMO])) break; if (sp > XB_SPIN_CAP) { atomicAdd(&bar[XB_TMO], 1u); break; } }
    }
    nloc = mine > 0u ? mine : 1u; nx = cnt > 0u ? cnt : 1u;
}
DI void xcd_barrier(const XcdBarrier& b, int wv) {
    asm volatile("s_waitcnt vmcnt(0)" ::: "memory");
    __syncthreads();
    if (wv == 0 && lane_id() == 0) {
        unsigned* bar = b.bar;
        unsigned bx = b.x; asm volatile("" : "+s"(bx));
        __builtin_amdgcn_s_waitcnt(0);
        unsigned nloc = b.st[0], nx = b.st[1];
        if (nloc == 0u) { xcd_barrier_complete(bar, bx, nloc, nx); b.st[0] = nloc; b.st[1] = nx; }
        const unsigned old = xb_add(&bar[XB_XSUB(bx)], 1u);
        const unsigned gen = old / nloc;
        if (old + 1u == (gen + 1u) * nloc) {
            __builtin_amdgcn_fence(__ATOMIC_RELEASE, "agent");
            asm volatile("s_waitcnt vmcnt(0)" ::: "memory");
            const unsigned og = xb_add(&bar[XB_TOP], 1u);
            const unsigned tg = og / nx;
            if (og + 1u == (tg + 1u) * nx) xb_add(&bar[XB_TOPGEN], 1u);
            else XB_SPIN(xb_ld(&bar[XB_TOPGEN]) == tg, bar);
            __builtin_amdgcn_fence(__ATOMIC_ACQUIRE, "agent");
            xb_add(&bar[XB_XGEN(bx)], 1u);
            asm volatile("s_waitcnt vmcnt(0)" ::: "memory");
        } else {
            XB_SPIN(xb_ld(&bar[XB_XGEN(bx)]) == gen, bar);
            __builtin_amdgcn_fence(__ATOMIC_ACQUIRE, "agent");
            asm volatile("s_waitcnt vmcnt(0)" ::: "memory");
        }
    }
    __syncthreads();
}

namespace pg8 {
typedef unsigned short bf16_t;
typedef short s16x8 __attribute__((ext_vector_type(8)));
constexpr int BM = 256, BK = 64, HALF = 128, HTB = HALF * BK * 2, STAGE_BYTES = 8 * HTB;
__host__ __device__ __forceinline__ int lds_byte(int r, int c) { const int st = (r >> 4) * 2 + (c >> 5), rr = r & 15, cc = c & 31, ob = rr * 64 + cc * 2; return st * 1024 + (ob ^ (((ob >> 9) & 1) << 5)); }
__host__ __device__ __forceinline__ void stage_rc(int b, int& R, int& C) { const int st = b / 1024, sb = b % 1024, swz = sb ^ (((sb >> 9) & 1) << 5); R = (st >> 1) * 16 + swz / 64; C = (st & 1) * 32 + (swz % 64) / 2; }
__host__ __device__ __forceinline__ int perm32(int rho) { const int n = rho >> 4, i = rho & 15; return 8 * (i >> 2) + 4 * n + (i & 3); }
struct Unit { int pm, pn, koff, nt, half; };
struct Gemm { const bf16_t* A; const bf16_t* Bt; int K; };

template <class Epi, class Sched, bool ALIGN_EPI = false, bool SP2 = false, bool HALFU = false>
__device__ __forceinline__ void gemm_phase(LAS unsigned char* lds, const Gemm g, const Sched& S, const Epi& E, int wv) {
    const int tid = opaque_tid(wv), wid = __builtin_amdgcn_readfirstlane(tid >> 6), lane = tid & 63, wr = wid >> 2, wc = wid & 3, fr = lane & 15, fq = lane >> 4;
    const int K = g.K;
    unsigned voffA[2], voffB[2];
#pragma unroll
    for (int i = 0; i < 2; ++i) { int R, C; stage_rc(tid * 16 + i * 8192, R, C); const int Rb = Epi::PERM ? ((R & ~31) + perm32(R & 31)) : R;
        voffA[i] = (unsigned)(R * K + C) * 2u; voffB[i] = (unsigned)(Rb * K + C) * 2u; }
    const size_t kstep = (size_t)(BK * 2);
    const size_t hstep = (size_t)HALF * K * 2;
    const size_t tstep = 2 * hstep;
    const unsigned ldsw = (unsigned)wid * 1024u;
    const int aoff = lds_byte(wr * 64 + fr, fq * 8), boff = lds_byte(wc * 32 + fr, fq * 8);
#define PG8_SA(b, h) (((b) * 2 + (h)) * HTB)
#define PG8_SB(b, h) ((4 + (b) * 2 + (h)) * HTB)
#define PG8_STAGE(bufoff, gbase, voff) do { _Pragma("unroll") for (int _i = 0; _i < 2; ++_i) \
        __builtin_amdgcn_global_load_lds((const unsigned*)((const char*)(gbase) + (voff)[_i]), (LAS unsigned*)(lds + (bufoff) + ldsw + _i * 8192), 16, 0, 0); } while (0)
#define PG8_LDA(dst, b, h) do { _Pragma("unroll") for (int m = 0; m < 4; ++m) _Pragma("unroll") for (int k = 0; k < 2; ++k) dst[m][k] = *(const LAS s16x8*)(lds + PG8_SA(b, h) + aoff + m * 2048 + k * 1024); } while (0)
#define PG8_LDB(dst, b, h) do { _Pragma("unroll") for (int n = 0; n < 2; ++n) _Pragma("unroll") for (int k = 0; k < 2; ++k) dst[n][k] = *(const LAS s16x8*)(lds + PG8_SB(b, h) + boff + n * 2048 + k * 1024); } while (0)
#define PG8_MMA(ai, bj, At, Bt) do { __builtin_amdgcn_s_setprio(1); _Pragma("unroll") for (int m = 0; m < 4; ++m) _Pragma("unroll") for (int n = 0; n < 2; ++n) _Pragma("unroll") for (int k = 0; k < 2; ++k) \
        acc[ai][bj][m][n] = __builtin_amdgcn_mfma_f32_16x16x32_bf16(Bt[n][k], At[m][k], acc[ai][bj][m][n], 0, 0, 0); __builtin_amdgcn_s_setprio(0); } while (0)
#define PG8_WAIT_V(n) asm volatile("s_waitcnt vmcnt(" #n ")" ::: "memory")
#define PG8_WAIT_L(n) asm volatile("s_waitcnt lgkmcnt(" #n ")" ::: "memory")
#define PG8_BAR __builtin_amdgcn_s_barrier()
#define PG8_SCHED __builtin_amdgcn_sched_barrier(0)
    Unit cur, nxt; int ui = 0;
    if (!S.next(0, cur)) return;
    f32x4 acc[2][2][4][2];
#pragma unroll
    for (int a = 0; a < 2; ++a)
#pragma unroll
        for (int b = 0; b < 2; ++b)
#pragma unroll
            for (int m = 0; m < 4; ++m)
#pragma unroll
                for (int n = 0; n < 2; ++n) acc[a][b][m][n] = (f32x4){0.f, 0.f, 0.f, 0.f};
    s16x8 At[4][2], B0[2][2], B1[2][2];
    const char* cA = (const char*)g.A + (size_t)cur.pm * tstep + cur.koff + (HALFU && cur.half == 2 ? hstep : 0); const char* cB = (const char*)g.Bt + (size_t)cur.pn * tstep + cur.koff;
    if constexpr (SP2) {
        PG8_STAGE(PG8_SB(0, 0), cB, voffB); PG8_STAGE(PG8_SB(0, 1), cB + hstep, voffB); PG8_STAGE(PG8_SA(0, 0), cA, voffA); PG8_STAGE(PG8_SA(0, 1), cA + hstep, voffA);
        if (wr == 1) PG8_BAR;
        PG8_WAIT_V(2); PG8_BAR;
        PG8_STAGE(PG8_SB(1, 0), cB + kstep, voffB); PG8_STAGE(PG8_SA(1, 0), cA + kstep, voffA); PG8_STAGE(PG8_SB(1, 1), cB + hstep + kstep, voffB);
        PG8_WAIT_V(6); PG8_BAR;
    } else {
        PG8_STAGE(PG8_SB(0, 0), cB, voffB); PG8_STAGE(PG8_SA(0, 0), cA, voffA); PG8_STAGE(PG8_SB(0, 1), cB + hstep, voffB); PG8_STAGE(PG8_SA(0, 1), cA + hstep, voffA);
        if (wr == 1) PG8_BAR;
        PG8_WAIT_V(4); PG8_BAR;
        PG8_STAGE(PG8_SB(1, 0), cB + kstep, voffB); PG8_STAGE(PG8_SA(1, 0), cA + kstep, voffA); PG8_STAGE(PG8_SB(1, 1), cB + hstep + kstep, voffB);
        PG8_WAIT_V(6); PG8_BAR;
    }
    for (;;) {
        const bool has_next = S.next(ui + 1, nxt);
        const char* nA = has_next ? (const char*)g.A + (size_t)nxt.pm * tstep + nxt.koff + (HALFU && nxt.half == 2 ? hstep : 0) : cA; const char* nB = has_next ? (const char*)g.Bt + (size_t)nxt.pn * tstep + nxt.koff : cB;
        const int nt = cur.nt; constexpr bool hf = HALFU;
        for (int t = 0; t < nt; t += 2) {
            const bool last = (t == nt - 2);
            const char* a1 = cA + (size_t)(t + 1) * kstep;
            const char* a2 = last ? nA : cA + (size_t)(t + 2) * kstep; const char* b2 = last ? nB : cB + (size_t)(t + 2) * kstep;
            const char* a3 = a2 + kstep; const char* b3 = b2 + kstep;
            if constexpr (SP2) {
            PG8_LDB(B0, 0, 0); PG8_LDB(B1, 0, 1); PG8_SCHED; PG8_LDA(At, 0, 0); PG8_STAGE(PG8_SA(1, 1), a1 + hstep, voffA);
            PG8_WAIT_V(8); PG8_WAIT_L(0); PG8_BAR; PG8_MMA(0, 0, At, B0); PG8_MMA(0, 1, At, B1); PG8_BAR; PG8_SCHED;
            if (!hf) PG8_LDA(At, 0, 1); PG8_STAGE(PG8_SB(0, 0), b2, voffB); PG8_STAGE(PG8_SB(0, 1), b2 + hstep, voffB); PG8_STAGE(PG8_SA(0, 0), a2, voffA);
            PG8_WAIT_V(8); PG8_WAIT_L(0); PG8_BAR; if (!hf) { PG8_MMA(1, 0, At, B0); PG8_MMA(1, 1, At, B1); } PG8_BAR; PG8_SCHED;
            PG8_LDB(B0, 1, 0); PG8_LDB(B1, 1, 1); PG8_SCHED; PG8_LDA(At, 1, 0); PG8_STAGE(PG8_SA(0, 1), a2 + hstep, voffA);
            PG8_WAIT_V(8); PG8_WAIT_L(0); PG8_BAR; PG8_MMA(0, 0, At, B0); PG8_MMA(0, 1, At, B1); PG8_BAR; PG8_SCHED;
            if (!hf) PG8_LDA(At, 1, 1); PG8_STAGE(PG8_SB(1, 0), b3, voffB); PG8_STAGE(PG8_SB(1, 1), b3 + hstep, voffB); PG8_STAGE(PG8_SA(1, 0), a3, voffA);
            PG8_WAIT_V(8); PG8_WAIT_L(0); PG8_BAR; if (!hf) { PG8_MMA(1, 0, At, B0); PG8_MMA(1, 1, At, B1); } PG8_BAR; PG8_SCHED;
            } else {
            PG8_LDB(B0, 0, 0); PG8_SCHED; PG8_LDA(At, 0, 0); PG8_STAGE(PG8_SA(1, 1), a1 + hstep, voffA);
            PG8_WAIT_L(8); PG8_BAR; PG8_WAIT_L(0); PG8_MMA(0, 0, At, B0); PG8_BAR; PG8_SCHED;
            PG8_LDB(B1, 0, 1); PG8_STAGE(PG8_SB(0, 0), b2, voffB);
            PG8_BAR; PG8_WAIT_L(0); PG8_MMA(0, 1, At, B1); PG8_BAR;
            PG8_LDA(At, 0, 1); PG8_STAGE(PG8_SA(0, 0), a2, voffA);
            PG8_BAR; PG8_WAIT_L(0); PG8_MMA(1, 0, At, B0); PG8_BAR; PG8_SCHED;
            PG8_STAGE(PG8_SB(0, 1), b2 + hstep, voffB);
            PG8_WAIT_V(6); PG8_BAR; PG8_MMA(1, 1, At, B1); PG8_BAR;
            PG8_LDB(B0, 1, 0); PG8_SCHED; PG8_LDA(At, 1, 0); PG8_STAGE(PG8_SA(0, 1), a2 + hstep, voffA);
            PG8_WAIT_L(8); PG8_BAR; PG8_WAIT_L(0); PG8_MMA(0, 0, At, B0); PG8_BAR; PG8_SCHED;
            PG8_LDB(B1, 1, 1); PG8_STAGE(PG8_SB(1, 0), b3, voffB);
            PG8_BAR; PG8_WAIT_L(0); PG8_MMA(0, 1, At, B1); PG8_BAR;
            PG8_LDA(At, 1, 1); PG8_STAGE(PG8_SA(1, 0), a3, voffA);
            PG8_BAR; PG8_WAIT_L(0); PG8_MMA(1, 0, At, B0); PG8_BAR; PG8_SCHED;
            PG8_STAGE(PG8_SB(1, 1), b3 + hstep, voffB);
            PG8_WAIT_V(6); PG8_BAR; PG8_MMA(1, 1, At, B1); PG8_BAR;
            }
        }
        if constexpr (ALIGN_EPI) { if (wr == 0) PG8_BAR; }
        E(acc, cur, wr, wc, fr, fq);
        if (!has_next) break;
#pragma unroll
        for (int a = 0; a < 2; ++a)
#pragma unroll
            for (int b = 0; b < 2; ++b)
#pragma unroll
                for (int m = 0; m < 4; ++m)
#pragma unroll
                    for (int n = 0; n < 2; ++n) acc[a][b][m][n] = (f32x4){0.f, 0.f, 0.f, 0.f};
        cur = nxt; cA = nA; cB = nB; ++ui;
        if constexpr (ALIGN_EPI) { if (wr == 1) PG8_BAR; }
    }
    PG8_WAIT_V(0);
    if constexpr (!ALIGN_EPI) { if (wr == 0) PG8_BAR; }
    PG8_BAR;
#undef PG8_SA
#undef PG8_SB
#undef PG8_STAGE
#undef PG8_LDA
#undef PG8_LDB
#undef PG8_MMA
#undef PG8_WAIT_V
#undef PG8_WAIT_L
#undef PG8_BAR
#undef PG8_SCHED
}
}
using pg8::Unit;
typedef float f32x2 __attribute__((ext_vector_type(2)));

DI u32x4 pack8(const f32x4 a, const f32x4 b) {
    f32x8 t; t[0] = a[0]; t[1] = a[1]; t[2] = a[2]; t[3] = a[3]; t[4] = b[0]; t[5] = b[1]; t[6] = b[2]; t[7] = b[3];
    return __builtin_bit_cast(u32x4, __builtin_convertvector(t, bf16x8));
}

struct Sched1 {
    int c, G, wbase, nu;
    DI bool next(int i, Unit& u) const {
        const int L = i * G + c; if (L >= nu) return false;
        u.koff = 0; u.nt = 32; u.half = 0;
        if (L < 1344) { const int xcd = L & 7, off = L >> 3; u.pm = 8 * xcd + (off & 7); u.pn = wbase + (off >> 3); }
        else { const int Lp = L - 1344, xcd = Lp & 7, off = Lp >> 3; u.pn = 8 * xcd + (off & 7); u.pm = wbase + 21 + (off >> 3); }
        return true; }
};
struct Sched1H {
    int c, G, wbase;
    DI bool next(int i, Unit& u) const {
        const int h = i * G + c; if (h >= 256) return false;
        const int xcd = h & 7, q = h >> 3, off = 24 + (q >> 1);
        u.koff = 0; u.nt = 32; u.pn = 8 * xcd + (off & 7); u.pm = wbase + 21 + (off >> 3); u.half = 1 + (q & 1);
        return true; }
};
struct Sched2 {
    int c, G, wbase;
    DI bool next(int i, Unit& u) const {
        const int L = i * G + c; if (L >= 448) return false;
        u.half = 0;
        if (L < 320) { const int xcd = L & 7, off = L >> 3; u.pm = 8 * xcd + (off & 7); u.pn = wbase + (off >> 3); const bool isq = (off >> 3) < 3; u.koff = isq ? 0 : 384 * 2; u.nt = isq ? 6 : 2; }
        else { const int Lp = L - 320, xcd = Lp & 7, off = Lp >> 3; u.pn = 8 * xcd + (off & 7); u.pm = wbase + 5 + (off >> 3); u.koff = 384 * 2; u.nt = 2; }
        return true; }
};
struct Sched3 {
    int c, G, wbase;
    DI bool next(int i, Unit& u) const {
        const int L = i * G + c; if (L >= 512) return false;
        const int xcd = L & 7, off = L >> 3; u.pm = 8 * xcd + (off & 7); u.pn = wbase + (off >> 3); u.koff = 0; u.nt = 32; u.half = 0;
        return true; }
};

struct Epi1 {
    static constexpr bool PERM = true;
    bf16* h; bf16* lat; bf16* vT; int wbase; float* ssq;
    const float* rs;
    DI void operator()(const f32x4 (&acc)[2][2][4][2], const Unit& u, int wr, int wc, int fr, int fq) const {
        if (u.pm < 64) {
            const int wt = u.pn - wbase;
            bf16* O; int ldc, colt;
            if (wt < 19) { O = h; ldc = LDH; colt = wt * 256; } else { O = lat; ldc = 512; colt = (wt - 19) * 256; }
            const int row0 = u.pm * 256 + wr * 64 + fr, col0 = colt + wc * 32 + 8 * fq;
            float sc[2][4];
#pragma unroll
            for (int ai = 0; ai < 2; ++ai)
#pragma unroll
                for (int m = 0; m < 4; ++m) sc[ai][m] = frsq(rs[row0 + ai * 128 + m * 16] * (1.f / DM) + EPS);
#pragma unroll
            for (int ai = 0; ai < 2; ++ai)
#pragma unroll
                for (int m = 0; m < 4; ++m) { bf16* rowp = O + (size_t)(row0 + ai * 128 + m * 16) * ldc + col0;
#pragma unroll
                    for (int bj = 0; bj < 2; ++bj) *(u32x4*)(rowp + bj * 128) = pack8(acc[ai][bj][m][0] * sc[ai][m], acc[ai][bj][m][1] * sc[ai][m]); }
            if (wt >= 19) {
#pragma unroll
                for (int ai = 0; ai < 2; ++ai)
#pragma unroll
                    for (int m = 0; m < 4; ++m) { float s2[2];
#pragma unroll
                        for (int bj = 0; bj < 2; ++bj) { const f32x4 a = acc[ai][bj][m][0] * sc[ai][m], b = acc[ai][bj][m][1] * sc[ai][m];
                            float t = a[0] * a[0] + a[1] * a[1] + a[2] * a[2] + a[3] * a[3] + b[0] * b[0] + b[1] * b[1] + b[2] * b[2] + b[3] * b[3];
                            t = xrow_sum(t); t = xhalf_sum(t); s2[bj] = t; }
                        if (fq == 0) { float* sq = ssq + (size_t)(row0 + ai * 128 + m * 16) * 2;
                            if (wt == 19) __hip_atomic_fetch_add(sq, s2[0] + s2[1], __ATOMIC_RELAXED, __HIP_MEMORY_SCOPE_AGENT);
                            else { __hip_atomic_fetch_add(sq, s2[0], __ATOMIC_RELAXED, __HIP_MEMORY_SCOPE_AGENT); __hip_atomic_fetch_add(sq + 1, s2[1], __ATOMIC_RELAXED, __HIP_MEMORY_SCOPE_AGENT); } } }
            }
        } else {
            const int ft = u.pm - wbase - 21;
            const int na = u.half ? 1 : 2;
            const int f0 = ft * 256 + (u.half == 2 ? 128 : 0) + wr * 64 + fr, tok0 = u.pn * 256 + wc * 32 + 8 * fq;
            f32x4 scc[2][2];
#pragma unroll
            for (int bj = 0; bj < 2; ++bj)
#pragma unroll
                for (int n = 0; n < 2; ++n)
#pragma unroll
                    for (int e = 0; e < 4; ++e) scc[bj][n][e] = frsq(rs[tok0 + bj * 128 + n * 4 + e] * (1.f / DM) + EPS);
            if (ft < 2) {
#pragma unroll
                for (int ai = 0; ai < 2; ++ai) if (ai < na)
#pragma unroll
                    for (int m = 0; m < 4; ++m) { bf16* rowp = vT + (size_t)(f0 + ai * 128 + m * 16) * T + tok0;
#pragma unroll
                        for (int bj = 0; bj < 2; ++bj) { f32x4 v0 = acc[ai][bj][m][0] * scc[bj][0], v1 = acc[ai][bj][m][1] * scc[bj][1];
#pragma unroll
                            for (int e = 0; e < 4; ++e) { v0[e] = gelu_t(v0[e]); v1[e] = gelu_t(v1[e]); }
                            *(u32x4*)(rowp + bj * 128) = pack8(v0, v1); } }
            } else {
#pragma unroll
                for (int ai = 0; ai < 2; ++ai) if (ai < na)
#pragma unroll
                    for (int m = 0; m < 4; ++m) { bf16* rowp = vT + (size_t)(f0 + ai * 128 + m * 16) * T + tok0;
#pragma unroll
                        for (int bj = 0; bj < 2; ++bj) *(u32x4*)(rowp + bj * 128) = pack8(acc[ai][bj][m][0] * scc[bj][0], acc[ai][bj][m][1] * scc[bj][1]); }
            }
        }
    }
};
struct Epi2 {
    static constexpr bool PERM = true;
    bf16* qc; bf16* kC; bf16* vCT; const float* stats; int wbase; float* statk; float* statq; const float* gq; const float* gk;
    DI void operator()(const f32x4 (&acc)[2][2][4][2], const Unit& u, int wr, int wc, int fr, int fq) const {
        if (u.pm < 64) {
            const int wt = u.pn - wbase;
            const int row0 = u.pm * 256 + wr * 64 + fr;
            f32x4 gg[2][2];
            if (wt < 3) {
#pragma unroll
                for (int bj = 0; bj < 2; ++bj) { const int c0 = wt * 256 + bj * 128 + wc * 32 + 8 * fq, d0 = c0 % 192;
#pragma unroll
                    for (int n = 0; n < 2; ++n)
#pragma unroll
                        for (int e = 0; e < 4; ++e) gg[bj][n][e] = gq[d0 + n * 4 + e] * (d0 < 128 ? gk[d0 + n * 4 + e] : 1.f); } }
            float scv[2][4];
#pragma unroll
            for (int ai = 0; ai < 2; ++ai)
#pragma unroll
                for (int m = 0; m < 4; ++m) scv[ai][m] = stats[(row0 + ai * 128 + m * 16) * 2 + (wt < 3 ? 0 : 1)];
#pragma unroll
            for (int ai = 0; ai < 2; ++ai)
#pragma unroll
                for (int m = 0; m < 4; ++m) { const int row = row0 + ai * 128 + m * 16; const float sc = frsq(scv[ai][m] * (wt < 3 ? 1.f / 384.f : 1.f / 128.f) + EPS);
#pragma unroll
                    for (int bj = 0; bj < 2; ++bj) {
                        bf16* dst = (wt < 3) ? qc + (size_t)row * 768 + wt * 256 + bj * 128 + wc * 32 + 8 * fq
                                             : kC + (size_t)row * 768 + ((wt - 3) * 2 + bj) * 192 + wc * 32 + 8 * fq;
                        if (wt < 3) {
                            const f32x4 a = acc[ai][bj][m][0] * sc, b = acc[ai][bj][m][1] * sc;
                            *(u32x4*)dst = pack8(a * gg[bj][0], b * gg[bj][1]);
                            float t = a[0] * a[0] + a[1] * a[1] + a[2] * a[2] + a[3] * a[3] + b[0] * b[0] + b[1] * b[1] + b[2] * b[2] + b[3] * b[3];
                            t = xrow_sum(t); t = xhalf_sum(t);
                            if (fq == 0) __hip_atomic_fetch_add(statq + (size_t)row * 4 + (wt * 256 + bj * 128 + wc * 32) / 192, t, __ATOMIC_RELAXED, __HIP_MEMORY_SCOPE_AGENT);
                        } else
                        *(u32x4*)dst = pack8(acc[ai][bj][m][0] * sc, acc[ai][bj][m][1] * sc); }
                    if (wt >= 3) {
#pragma unroll
                        for (int bj = 0; bj < 2; ++bj) { const f32x4 a = acc[ai][bj][m][0] * sc, b = acc[ai][bj][m][1] * sc;
                            float t = a[0] * a[0] + a[1] * a[1] + a[2] * a[2] + a[3] * a[3] + b[0] * b[0] + b[1] * b[1] + b[2] * b[2] + b[3] * b[3];
                            t = xrow_sum(t); t = xhalf_sum(t);
                            if (fq == 0) __hip_atomic_fetch_add(statk + (size_t)row * 4 + (wt - 3) * 2 + bj, t, __ATOMIC_RELAXED, __HIP_MEMORY_SCOPE_AGENT); } } }
        } else {
            const int ft = u.pm - wbase - 5;
            const int f0 = ft * 256 + wr * 64 + fr, tok0 = u.pn * 256 + wc * 32 + 8 * fq;
            f32x4 sc[2][2];
#pragma unroll
            for (int bj = 0; bj < 2; ++bj)
#pragma unroll
                for (int n = 0; n < 2; ++n)
#pragma unroll
                    for (int e = 0; e < 4; ++e) sc[bj][n][e] = frsq(stats[(tok0 + bj * 128 + n * 4 + e) * 2 + 1] * (1.f / 128.f) + EPS);
#pragma unroll
            for (int ai = 0; ai < 2; ++ai)
#pragma unroll
                for (int m = 0; m < 4; ++m) { bf16* rowp = vCT + (size_t)(f0 + ai * 128 + m * 16) * T + tok0;
#pragma unroll
                    for (int bj = 0; bj < 2; ++bj) *(u32x4*)(rowp + bj * 128) = pack8(acc[ai][bj][m][0] * sc[bj][0], acc[ai][bj][m][1] * sc[bj][1]); }
        }
    }
};
template <bool L0>
struct Epi3 {
    static constexpr bool PERM = false;
    const float* xin; const bf16* xb; float* out; bf16* x1b; float* ssq1; int wbase;
    DI void operator()(const f32x4 (&acc)[2][2][4][2], const Unit& u, int wr, int wc, int fr, int fq) const {
        const int row0 = u.pm * 256 + wr * 64 + fr, col0 = (u.pn - wbase) * 256 + wc * 32 + 4 * fq;
#pragma unroll
        for (int ai = 0; ai < 2; ++ai)
#pragma unroll
            for (int mh = 0; mh < 2; ++mh) {
                if constexpr (L0) {
                    bf16x4 xv[2][2][2];
#pragma unroll
                    for (int m2 = 0; m2 < 2; ++m2) { const size_t ro = (size_t)(row0 + ai * 128 + (mh * 2 + m2) * 16) * DM + col0;
#pragma unroll
                        for (int bj = 0; bj < 2; ++bj)
#pragma unroll
                            for (int n = 0; n < 2; ++n) xv[m2][bj][n] = *(const bf16x4*)(x1b + ro + bj * 128 + n * 16); }
#pragma unroll
                    for (int m2 = 0; m2 < 2; ++m2) { const int row = row0 + ai * 128 + (mh * 2 + m2) * 16; const size_t ro = (size_t)row * DM + col0; float t = 0.f;
#pragma unroll
                        for (int bj = 0; bj < 2; ++bj)
#pragma unroll
                            for (int n = 0; n < 2; ++n) { const f32x4 v = __builtin_convertvector(xv[m2][bj][n], f32x4) + acc[ai][bj][mh * 2 + m2][n];
                                t += v[0] * v[0] + v[1] * v[1] + v[2] * v[2] + v[3] * v[3];
                                *(bf16x4*)(x1b + ro + bj * 128 + n * 16) = __builtin_convertvector(v, bf16x4); }
                        t = xrow_sum(t); t = xhalf_sum(t);
                        if (fq == 0) __hip_atomic_fetch_add(ssq1 + row, t, __ATOMIC_RELAXED, __HIP_MEMORY_SCOPE_AGENT); }
                } else {
                    bf16x4 xv[2][2][2];
#pragma unroll
                    for (int m2 = 0; m2 < 2; ++m2) { const size_t ro = (size_t)(row0 + ai * 128 + (mh * 2 + m2) * 16) * DM + col0;
#pragma unroll
                        for (int bj = 0; bj < 2; ++bj)
#pragma unroll
                            for (int n = 0; n < 2; ++n) xv[m2][bj][n] = *(const bf16x4*)(xb + ro + bj * 128 + n * 16); }
#pragma unroll
                    for (int m2 = 0; m2 < 2; ++m2) { const size_t ro = (size_t)(row0 + ai * 128 + (mh * 2 + m2) * 16) * DM + col0;
#pragma unroll
                        for (int bj = 0; bj < 2; ++bj)
#pragma unroll
                            for (int n = 0; n < 2; ++n) *(f32x4*)(out + ro + bj * 128 + n * 16) = __builtin_convertvector(xv[m2][bj][n], f32x4) + acc[ai][bj][mh * 2 + m2][n]; }
                }
            }
    }
};

struct TSub { const float* src; bf16* dst; int valid; };
DI void transpose_tile4(LAS float* lt, const TSub (&sub)[4], int src_ld, const float* gain, int dst_ld, int tid) {
    const int kk = tid >> 4, n4 = (tid & 15) * 4;
    f32x4 v[4][2];
#pragma unroll
    for (int q = 0; q < 4; ++q)
#pragma unroll
        for (int pass = 0; pass < 2; ++pass) {
            v[q][pass] = (f32x4){0.f, 0.f, 0.f, 0.f};
            if (sub[q].src && n4 < sub[q].valid) v[q][pass] = __builtin_nontemporal_load((const f32x4*)(sub[q].src + (size_t)(kk + 32 * pass) * src_ld + n4));
        }
    const float g0 = gain ? gain[kk] : 1.f, g1 = gain ? gain[kk + 32] : 1.f;
    const int n = tid >> 3, k8 = (tid & 7) * 8;
#pragma unroll
    for (int q = 0; q < 4; ++q) {
#pragma unroll
        for (int e = 0; e < 4; ++e) { lt[kk * 65 + n4 + e] = v[q][0][e] * g0; lt[(kk + 32) * 65 + n4 + e] = v[q][1][e] * g1; }
        __syncthreads();
        float o[8];
#pragma unroll
        for (int j = 0; j < 8; ++j) o[j] = lt[(k8 + j) * 65 + n];
        *(bf16x8*)(sub[q].dst + (size_t)n * dst_ld + k8) = cvt8(o);
        __syncthreads();
    }
}
DI int wi_orig(int n0, int& valid) {
    valid = 64;
    if (n0 < 512) return n0;
    if (n0 < 1024) return 1024 + (n0 - 512);
    if (n0 < 1536) return 1536 + (n0 - 1024);
    if (n0 < 2048) return 2176 + (n0 - 1536);
    if (n0 < 2560) return 2760 + (n0 - 2048);
    if (n0 < 3072) return 3848 + (n0 - 2560);
    if (n0 < 3584) return 4360 + (n0 - 3072);
    if (n0 < 4096) return 4872 + (n0 - 3584);
    if (n0 < 4608) return 5896 + (n0 - 4096);
    if (n0 == 4608) return 2048;
    if (n0 == 4672) return 2688;
    if (n0 == 4736) return 3784;
    if (n0 == 4800) { valid = 8; return 2752; }
    if (n0 < 5248) return 3272 + (n0 - 4864);
    if (n0 < 5376) return 3656 + (n0 - 5248);
    if (n0 < 5888) return 512 + (n0 - 5376);
    if (n0 < 6400) return 5384 + (n0 - 5888);
    if (n0 == 6400) return 2112;
    return -1;
}
DI int t5_bucket(int rel) {
    const int n = rel < 0 ? -rel : rel; const int ret = rel > 0 ? 16 : 0;
    int v; if (n < 8) v = n; else { v = 33 - __clz(n * n); if (v > 15) v = 15; }
    return ret + v;
}
DI void prep_x_rows(const float* xin, bf16* xb, unsigned char* ws, int gw, int nw, int lane) {
    float* statx = (float*)(ws + OFF_STATX); float* statl = (float*)(ws + OFF_STATL); float* statk = (float*)(ws + OFF_STATK); float* statq = (float*)(ws + OFF_STATQ);
    for (int row = gw; row < T; row += nw) {
        f32x4 v[8]; float ss = 0.f;
#pragma unroll
        for (int i = 0; i < 8; ++i) { v[i] = *(const f32x4*)(xin + (size_t)row * DM + i * 256 + lane * 4); ss += v[i][0] * v[i][0] + v[i][1] * v[i][1] + v[i][2] * v[i][2] + v[i][3] * v[i][3]; }
        ss = sum8(ss); ss += dppf<DPP_XOR8>(ss); ss = xrow_sum(ss); ss = xhalf_sum(ss);
#pragma unroll
        for (int i = 0; i < 8; ++i) *(bf16x4*)(xb + (size_t)row * DM + i * 256 + lane * 4) = __builtin_convertvector(v[i], bf16x4);
        if (lane == 0) { statx[row] = ss; statx[T + row] = 0.f; }
        if (lane < 4) { statl[(size_t)row * 4 + lane] = 0.f; statk[(size_t)row * 4 + lane] = 0.f; statk[(size_t)T * 4 + (size_t)row * 4 + lane] = 0.f;
            statq[(size_t)row * 4 + lane] = 0.f; statq[(size_t)T * 4 + (size_t)row * 4 + lane] = 0.f; }
    }
}
DI void prep_weights(const Params& p, int l, LAS float* lt, int j0, int step, int tid) {
    bf16* U1 = (bf16*)(p.ws + OFF_U1); bf16* U2 = (bf16*)(p.ws + OFF_U2); bf16* U3 = (bf16*)(p.ws + OFF_U3);
    for (int j = j0; j < 1144; j += step) {
        TSub sub[4];
        if (j < 832) {
            const int ntg = j >> 5, kt = j & 31;
#pragma unroll
            for (int q = 0; q < 4; ++q) { const int nt = ntg * 4 + q; int valid; const int oc = wi_orig(nt * 64, valid);
                sub[q].src = oc < 0 ? nullptr : p.w_in + (size_t)l * DM * INC + (size_t)(kt * 64) * INC + oc; sub[q].valid = valid;
                sub[q].dst = U1 + (size_t)(64 + 26 * l) * 256 * 2048 + (size_t)(nt * 64) * 2048 + kt * 64; }
            transpose_tile4(lt, sub, INC, p.norm_g + l * DM + kt * 64, 2048, tid);
        } else if (j < 1088) {
            const int jj = j - 832, ntg = jj >> 5, kt = jj & 31;
#pragma unroll
            for (int q = 0; q < 4; ++q) { const int nt = ntg * 4 + q;
                sub[q].src = p.w_out + (size_t)l * DM * DM + (size_t)(kt * 64) * DM + nt * 64; sub[q].valid = 64;
                sub[q].dst = U3 + (size_t)(64 + 8 * l) * 256 * 2048 + (size_t)(nt * 64) * 2048 + kt * 64; }
            transpose_tile4(lt, sub, DM, nullptr, 2048, tid);
        } else {
            const int jj = j - 1088, ntg = jj >> 3, kt = jj & 7;
            const bool isq = ntg < 3; const bool live = isq ? (kt < 6) : (kt >= 6);
#pragma unroll
            for (int q = 0; q < 4; ++q) { const int nt = ntg * 4 + q; const float* src = nullptr;
                if (live) { if (isq) src = p.c_w_qb + (size_t)l * 384 * 768 + (size_t)(kt * 64) * 768 + nt * 64;
                    else { const int np = (nt - 12) * 64; const int oc = np < 512 ? (np >> 7) * 256 + (np & 127) : ((np - 512) >> 7) * 256 + 128 + ((np - 512) & 127);
                        src = p.c_w_kvb + (size_t)l * 128 * 1024 + (size_t)((kt - 6) * 64) * 1024 + oc; } }
                sub[q].src = src; sub[q].valid = 64; sub[q].dst = U2 + (size_t)(64 + 7 * l) * 256 * 512 + (size_t)(nt * 64) * 512 + kt * 64; }
            const float* gain = !live ? nullptr : (isq ? p.c_qa_gain + l * 384 + kt * 64 : p.c_kva_gain + l * 128 + (kt - 6) * 64);
            transpose_tile4(lt, sub, isq ? 768 : 1024, gain, 512, tid);
        }
    }
}
DI void phase_prep(const Params& p, LAS unsigned char* lds, int G, int wv) {
    const int tid = opaque_tid(wv), blk = blockIdx.x;
    prep_weights(p, 0, (LAS float*)lds, blk, G, tid);
    bf16* U1 = (bf16*)(p.ws + OFF_U1);
    const int gt = blk * 512 + tid, nthr = G * 512;
    bf16* Wa = (bf16*)(p.ws + OFF_WA);
    for (int e = gt; e < 2 * 4 * 128 * 128; e += nthr) { const int jx = e & 127, ix = (e >> 7) & 127; Wa[e] = (bf16)(((jx >> 6) <= (ix >> 6)) ? p.a_ws[e] : 0.f); }
    float* ct = (float*)(p.ws + OFF_COS); float* st = (float*)(p.ws + OFF_SIN);
    for (int e = gt; e < 2048 * 32; e += nthr) { const int pos = e >> 5, i = e & 31; const float inv = exp2f(-(float)(2 * i) * (13.287712379549449f / 64.f)); const float ang = (float)pos * inv;
        ct[e] = cosf(ang); st[e] = sinf(ang); }
    float* t5 = (float*)(p.ws + OFF_T5);
    for (int e = gt; e < 8 * 2112; e += nthr) { const int hd = e / 2112, idx = e % 2112; t5[e] = p.t5_bias[t5_bucket(idx - 2047) * 8 + hd] * LOG2E; }
    float* dt = (float*)(p.ws + OFF_DT);
    for (int e = gt; e < 2 * 8 * 264; e += nthr) { const int l = e / (8 * 264), hd = (e / 264) & 7, i = e % 264; dt[e] = (i < 257) ? p.d_rel_bias[(size_t)l * 257 * 8 + i * 8 + hd] * LOG2E : 0.f; }
    prep_x_rows(p.x, U1, p.ws, (tid >> 6) * G + blk, 8 * G, tid & 63);
}

DI unsigned fkey(float f) { unsigned b = __float_as_uint(f); if (b == 0x80000000u) b = 0u; return (b & 0x80000000u) ? ~b : (b | 0x80000000u); }
DI unsigned wave_sum_u32(unsigned x) {
    x += (unsigned)__builtin_amdgcn_update_dpp(0, (int)x, 0xB1, 0xF, 0xF, true);
    x += (unsigned)__builtin_amdgcn_update_dpp(0, (int)x, 0x4E, 0xF, 0xF, true);
    x += (unsigned)__builtin_amdgcn_update_dpp(0, (int)x, 0x141, 0xF, 0xF, true);
    x += (unsigned)__builtin_amdgcn_update_dpp(0, (int)x, 0x140, 0xF, 0xF, true);
    return (unsigned)__builtin_amdgcn_readlane((int)x, 0) + (unsigned)__builtin_amdgcn_readlane((int)x, 16) + (unsigned)__builtin_amdgcn_readlane((int)x, 32) + (unsigned)__builtin_amdgcn_readlane((int)x, 48);
}
template <int NMX>
DI unsigned long long sel_ties(const unsigned (&u)[NMX], unsigned prefix, int lane) {
    unsigned long long myw = 0ull; int cgt = 0;
#pragma unroll
    for (int m = 0; m < NMX; ++m) cgt += __popcll(__ballot(u[m] > prefix));
    int need = 256 - cgt;
#pragma unroll
    for (int m = 0; m < NMX; ++m) {
        const unsigned long long gtm = __ballot(u[m] > prefix), eqm = __ballot(u[m] == prefix);
        const int ne = __popcll(eqm); const int take = need < ne ? need : ne; need -= take;
        const unsigned long long below = (lane == 0) ? 0ull : (~0ull >> (64 - lane));
        const bool sel = (u[m] == prefix) && (__popcll(eqm & below) < take);
        const unsigned long long bm = gtm | __ballot(sel);
        myw = (lane == m) ? bm : myw; }
    return myw;
}
template <int NMX>
DI void sel_rows2(const LAS float* row0, const LAS float* row1, int nm, int lane, unsigned long long& w0, unsigned long long& w1) {
    unsigned u0[NMX], u1[NMX];
#pragma unroll
    for (int m = 0; m < NMX; ++m) { u0[m] = (m < nm) ? fkey(row0[m * 64 + lane]) : 0u; u1[m] = (m < nm) ? fkey(row1[m * 64 + lane]) : 0u; }
    unsigned p0 = 0u, p1 = 0u; bool e0 = false, e1 = false;
    for (int bit = 31; bit >= 0; --bit) {
        const unsigned c0 = p0 | (1u << bit), c1 = p1 | (1u << bit);
        unsigned n0 = 0u, n1 = 0u;
#define CNT4(n, c, a0_, a1_, a2_, a3_) asm("v_cmp_le_u32_e64 s[20:21], %1, %2\n\tv_cmp_le_u32_e64 s[22:23], %1, %3\n\tv_cmp_le_u32_e64 s[24:25], %1, %4\n\tv_cmp_le_u32_e64 s[26:27], %1, %5\n\t" \
            "v_addc_co_u32_e64 %0, vcc, 0, %0, s[20:21]\n\tv_addc_co_u32_e64 %0, vcc, 0, %0, s[22:23]\n\tv_addc_co_u32_e64 %0, vcc, 0, %0, s[24:25]\n\tv_addc_co_u32_e64 %0, vcc, 0, %0, s[26:27]" \
            : "+v"(n) : "s"(c), "v"(a0_), "v"(a1_), "v"(a2_), "v"(a3_) : "s20", "s21", "s22", "s23", "s24", "s25", "s26", "s27", "vcc")
        const unsigned cs0 = (unsigned)__builtin_amdgcn_readfirstlane((int)c0), cs1 = (unsigned)__builtin_amdgcn_readfirstlane((int)c1);
#pragma unroll
        for (int m = 0; m < NMX; m += 4) { CNT4(n0, cs0, u0[m], u0[m + 1], u0[m + 2], u0[m + 3]); CNT4(n1, cs1, u1[m], u1[m + 1], u1[m + 2], u1[m + 3]); }
#undef CNT4
        const unsigned tot = wave_sum_u32(n0 | (n1 << 16));
        const unsigned t0 = tot & 0xffffu, t1 = tot >> 16;
        if (!e0) { if (t0 >= 256u) p0 = c0; if (t0 == 256u) e0 = true; }
        if (!e1) { if (t1 >= 256u) p1 = c1; if (t1 == 256u) e1 = true; }
        if (e0 && e1) break;
    }
    if (e0) { w0 = 0ull;
#pragma unroll
        for (int m = 0; m < NMX; ++m) { const unsigned long long bm = __ballot(u0[m] >= p0); w0 = (lane == m) ? bm : w0; }
    } else w0 = sel_ties<NMX>(u0, p0, lane);
    if (e1) { w1 = 0ull;
#pragma unroll
        for (int m = 0; m < NMX; ++m) { const unsigned long long bm = __ballot(u1[m] >= p1); w1 = (lane == m) ? bm : w1; }
    } else w1 = sel_ties<NMX>(u1, p1, lane);
}
struct SelRegs { bf16x8 qf[8][2]; bf16x8 wv; bf16x8 a0[4], a1[4]; };
#define SEL_LOADK(A0, A1, trip) do { _Pragma("unroll") for (int u = 0; u < 4; ++u) { const int kt = w + 32 * (trip) + 8 * u; const int ktc = kt < ntile ? kt : w; \
        const bf16* krow = h + (size_t)(b * S + ktc * 16 + fr) * LDH + H_BIK + fq * 8; A0[u] = *(const bf16x8*)krow; A1[u] = *(const bf16x8*)(krow + 32); } } while (0)
DI void sel_load(SelRegs& R, const bf16* h, int b, int qg, int w, int fr, int fq) {
    const int s0 = qg * 16, t0 = b * S + s0, ntile = ((s0 >> 6) + 1) * 4;
    const bf16* qrow = h + (size_t)(t0 + fr) * LDH;
#pragma unroll
    for (int hd = 0; hd < 8; ++hd)
#pragma unroll
        for (int ks = 0; ks < 2; ++ks) R.qf[hd][ks] = *(const bf16x8*)(qrow + H_BIQ + hd * 64 + ks * 32 + fq * 8);
    R.wv = *(const bf16x8*)(qrow + H_BIW);
    SEL_LOADK(R.a0, R.a1, 0);
}
DI void sel_scores(SelRegs& R, const bf16* h, int b, int qg, LAS float* sc, int w, int fr, int fq) {
    const int s0 = qg * 16, ntile = ((s0 >> 6) + 1) * 4, ntrip = (ntile + 31) >> 5;
    float wgt[8];
#pragma unroll
    for (int hd = 0; hd < 8; ++hd) wgt[hd] = (float)R.wv[hd] * C_IW;
#define SEL_COMPUTE(A0, A1, trip) do { _Pragma("unroll") for (int u = 0; u < 4; ++u) { const int kt = w + 32 * (trip) + 8 * u; \
        if (kt < ntile) { float s4[4] = {0.f, 0.f, 0.f, 0.f}; \
            _Pragma("unroll") for (int hd = 0; hd < 8; ++hd) { f32x4 a = {0.f, 0.f, 0.f, 0.f}; a = MFMA16(A0[u], R.qf[hd][0], a); a = MFMA16(A1[u], R.qf[hd][1], a); \
                _Pragma("unroll") for (int r = 0; r < 4; ++r) { const float rl = relu_i(a[r]); asm("v_fma_f32 %0, %1, %2, %0" : "+v"(s4[r]) : "v"(wgt[hd]), "v"(rl)); } } \
            *(LAS f32x4*)(sc + fr * SCLD + kt * 16 + fq * 4) = (f32x4){s4[0], s4[1], s4[2], s4[3]}; } } } while (0)
    bf16x8 b0[4], b1[4];
    for (int tp = 0; tp < ntrip; tp += 2) {
        SEL_LOADK(b0, b1, tp + 1);
        SEL_COMPUTE(R.a0, R.a1, tp);
        if (tp + 1 >= ntrip) break;
        SEL_LOADK(R.a0, R.a1, tp + 2);
        SEL_COMPUTE(b0, b1, tp + 1);
    }
#undef SEL_COMPUTE
}
#undef SEL_LOADK
DI void sel_select(unsigned* mask, int b, int qg, LAS float* sc, int w, int lane) {
    const int s0 = qg * 16, t0 = b * S + s0, nm = (s0 >> 6) + 1;
    const int q = 2 * w;
    unsigned long long w0 = ~0ull, w1 = ~0ull;
    if (nm <= 4) { }
    else if (nm <= 8) sel_rows2<8>(sc + q * SCLD, sc + (q + 1) * SCLD, nm, lane, w0, w1);
    else if (nm <= 16) sel_rows2<16>(sc + q * SCLD, sc + (q + 1) * SCLD, nm, lane, w0, w1);
    else if (nm <= 24) sel_rows2<24>(sc + q * SCLD, sc + (q + 1) * SCLD, nm, lane, w0, w1);
    else sel_rows2<32>(sc + q * SCLD, sc + (q + 1) * SCLD, nm, lane, w0, w1);
    if (lane < nm) { *(unsigned long long*)(mask + (size_t)(t0 + q) * 64 + 2 * lane) = w0; *(unsigned long long*)(mask + (size_t)(t0 + q + 1) * 64 + 2 * lane) = w1; }
}

DI void norm8(float (&x)[8], const float (&gain)[8], float scale) {
    float ss = 0.f;
#pragma unroll
    for (int j = 0; j < 8; ++j) ss += x[j] * x[j];
    ss = sum8(ss);
    const float rstd = frsq(ss * (1.f / 64.f) + EPS) * scale;
#pragma unroll
    for (int j = 0; j < 8; ++j) x[j] = x[j] * rstd * gain[j];
}
struct P1Gains { float bq[8], dq[8], dk[8], bk[8], kr[8]; float* sk; };
template <int NR>
DI void post1_rows(const Params& p, const P1Gains& g, const int (&t)[NR], int lane) {
    bf16x8 vdk[NR], vk[NR], vkr[NR]; f32x4 kcs[NR][2], ksn[NR][2];
#pragma unroll
    for (int i = 0; i < NR; ++i) {
        const bf16* hrow = (const bf16*)(p.ws + OFF_H) + (size_t)t[i] * LDH;
        vdk[i] = *(const bf16x8*)(hrow + H_DK + lane * 8);
        vk[i] = *(const bf16x8*)(hrow + H_BK + (lane & 7) * 8);
        vkr[i] = *(const bf16x8*)(hrow + H_CKR + (lane & 7) * 8);
        { const float* ct = (const float*)(p.ws + OFF_COS) + (size_t)(t[i] & (S - 1)) * 32 + (lane & 3) * 8; const float* sn = (const float*)(p.ws + OFF_SIN) + (size_t)(t[i] & (S - 1)) * 32 + (lane & 3) * 8;
          kcs[i][0] = *(const f32x4*)ct; kcs[i][1] = *(const f32x4*)(ct + 4); ksn[i][0] = *(const f32x4*)sn; ksn[i][1] = *(const f32x4*)(sn + 4); }
    }
#pragma unroll
    for (int i = 0; i < NR; ++i) {
        bf16* hrow = (bf16*)(p.ws + OFF_H) + (size_t)t[i] * LDH;
        float x[8];
#pragma unroll
        for (int j = 0; j < 8; ++j) x[j] = (float)vdk[i][j];
        norm8(x, g.dk, 1.f); *(bf16x8*)(hrow + H_DK + lane * 8) = cvt8(x);
#pragma unroll
        for (int j = 0; j < 8; ++j) x[j] = (float)vk[i][j];
        norm8(x, g.bk, 1.f); if (lane < 8) *(bf16x8*)(hrow + H_BK + lane * 8) = cvt8(x);
        { float ss = 0.f, xg[8], o8[8];
#pragma unroll
          for (int j = 0; j < 8; ++j) { const float xr = (float)vkr[i][j]; ss += xr * xr; xg[j] = xr * g.kr[j]; }
          ss = sum8(ss);
#pragma unroll
          for (int j = 0; j < 8; ++j) { const float ot = dpp_xor4(xg[j]), cs = kcs[i][j >> 2][j & 3], si = ksn[i][j >> 2][j & 3];
              o8[j] = (lane & 4) ? ot * si + xg[j] * cs : xg[j] * cs - ot * si; }
          if (lane < 32) *(bf16x8*)((bf16*)(p.ws + OFF_KC) + (size_t)t[i] * 768 + (lane >> 3) * 192 + 128 + (lane & 7) * 8) = cvt8(o8);
          if (lane < 4) __hip_atomic_fetch_add(g.sk + (size_t)t[i] * 4 + lane, ss, __ATOMIC_RELAXED, __HIP_MEMORY_SCOPE_AGENT); }
    }
}

struct AttnWave { const bf16* Q; int ldq; const bf16* Z; bf16* Y; int s0, kbeg, kend; int hd; };
template <int DK, int DV> struct AttnCfg {
    static constexpr int KST = DK * 2 + 16, VST = 144;
    static constexpr int KBYTES = 64 * KST, VBYTES = DV * VST, RKB = (DK == 192) ? 256 : 0, STG = KBYTES + VBYTES + RKB;
    static constexpr int CPR = DK / 8, NKL = (64 * CPR) / 512, NVL = (DV * 8) / 512;
    static constexpr int TAB_OFF = 2 * STG, MSK_OFF = TAB_OFF + 8 * 256 * 4, MSK_LD = 65;
};
template <int DK, int DV, int MODE>
DI void attn_stage(LAS unsigned char* kb, const int k0, const AttnWave& aw, const bf16x8 (&qf)[DK / 16], f32x16 (&o)[DV / 32], float& m_run, float& l0, float& l1, f32x16& bmv,
                   const float bfar, const LAS float* wtab, const LAS unsigned* lmsk, const int r, const int hh, const int pr) {
    typedef AttnCfg<DK, DV> C;
    constexpr int J = (DK == 64) ? 2 : 1;
    LAS unsigned char* vb = kb + C::KBYTES;
    if (!(k0 >= aw.kbeg && k0 < aw.kend)) return;
#pragma unroll
    for (int g0 = 0; g0 < 2; g0 += J) {
        const bool first = (k0 + 32 * g0 == aw.kbeg);
        f32x16 st[J];
        constexpr int NKF = DK / 16 < 8 ? DK / 16 : 8;
        bf16x8 kf[J][NKF];
#pragma unroll
        for (int j = 0; j < J; ++j) {
            if (MODE == 0) {
#pragma unroll
                for (int i = 0; i < 16; ++i) st[j][i] = 0.f;
            }
#pragma unroll
            for (int s = 0; s < NKF; ++s) kf[j][s] = *(const LAS bf16x8*)(kb + (32 * (g0 + j) + pr) * C::KST + 16 * hh + 32 * s);
        }
        f32x4 rk0, rk1, rk2, rk3;
        if (MODE == 0) { const LAS float* rkp = (const LAS float*)(vb + C::VBYTES) + 32 * g0 + 8 * hh;
            rk0 = *(const LAS f32x4*)rkp; rk1 = *(const LAS f32x4*)(rkp + 4); rk2 = *(const LAS f32x4*)(rkp + 16); rk3 = *(const LAS f32x4*)(rkp + 20); }
        __builtin_amdgcn_sched_barrier(0);
#pragma unroll
        for (int s = 0; s < DK / 16; ++s)
#pragma unroll
            for (int j = 0; j < J; ++j) {
                if (MODE != 0 && s == 0) {
                    const int kk0 = k0 + 32 * (g0 + j);
                    if (kk0 + 31 + 128 <= aw.s0) st[j] = MFMA32(kf[j][0], qf[0], bmv);
                    else {
                        const int base = kk0 + 8 * hh - (aw.s0 + r);
                        float ci[16];
#pragma unroll
                        for (int i = 0; i < 16; ++i) { const float wt = wtab[base + 16 * (i >> 3) + (i & 7) + 192];
                            asm("v_sub_f32 %0, %1, %2" : "=v"(ci[i]) : "v"(wt), "v"(m_run)); }
                        f32x16 cv;
#pragma unroll
                        for (int i = 0; i < 16; ++i) cv[i] = ci[i];
                        st[j] = MFMA32(kf[j][0], qf[0], cv);
                    }
                } else st[j] = MFMA32(kf[j][s % NKF], qf[s], st[j]);
                if (s + NKF < DK / 16) kf[j][s % NKF] = *(const LAS bf16x8*)(kb + (32 * (g0 + j) + pr) * C::KST + 16 * hh + 32 * (s + NKF)); }
        bf16x8 vf[J][DV / 32][2];
#pragma unroll
        for (int j = 0; j < J; ++j)
#pragma unroll
            for (int d = 0; d < DV / 32; ++d)
#pragma unroll
                for (int s2 = 0; s2 < 2; ++s2) vf[j][d][s2] = *(const LAS bf16x8*)(vb + (32 * d + r) * C::VST + (32 * (g0 + j) + 16 * s2 + 8 * hh) * 2);
        __builtin_amdgcn_sched_barrier(0);
        if (MODE == 0) {
#pragma unroll
            for (int i = 0; i < 4; ++i) { st[0][i] = __builtin_fmaf(st[0][i], rk0[i], -m_run); st[0][4 + i] = __builtin_fmaf(st[0][4 + i], rk1[i], -m_run);
                st[0][8 + i] = __builtin_fmaf(st[0][8 + i], rk2[i], -m_run); st[0][12 + i] = __builtin_fmaf(st[0][12 + i], rk3[i], -m_run); }
        }
        float mx = fmaxf(fmaxf(st[0][0], st[0][1]), st[0][2]);
#pragma unroll
        for (int i = 3; i < 15; i += 2) mx = fmaxf(fmaxf(mx, st[0][i]), st[0][i + 1]);
        mx = fmaxf(mx, st[0][15]);
        if (J == 2) {
#pragma unroll
            for (int i = 0; i < 16; i += 2) mx = fmaxf(fmaxf(mx, st[J - 1][i]), st[J - 1][i + 1]);
        }
        mx = xhalf_max(mx);
        if (first || !__all(mx <= 8.f)) {
            const float d = first ? mx : fmaxf(mx, 0.f), alpha = fexp2(-d);
            m_run += d; l0 *= alpha; l1 *= alpha;
            if (MODE != 0) { const float bm = bfar - m_run;
#pragma unroll
                for (int i = 0; i < 16; ++i) bmv[i] = bm; }
#pragma unroll
            for (int dd = 0; dd < DV / 32; ++dd)
#pragma unroll
                for (int i = 0; i < 16; ++i) o[dd][i] *= alpha;
#pragma unroll
            for (int j = 0; j < J; ++j)
#pragma unroll
                for (int i = 0; i < 16; ++i) st[j][i] -= d;
        }
#pragma unroll
        for (int j = 0; j < J; ++j) {
            float pv[16];
            if (MODE == 1) {
#pragma unroll
                for (int i = 0; i < 16; ++i) pv[i] = fexp2(st[j][i]);
                const unsigned mw = lmsk[r * C::MSK_LD + ((k0 + 32 * (g0 + j)) >> 5)] >> (8 * hh);
#define MASK_AND(i) asm("v_bfe_i32 %0, %1, %2, 1\n\tv_and_b32 %0, %0, %3" : "=&v"(pv[i]) : "v"(mw), "n"(16 * ((i) >> 3) + ((i) & 7)), "v"(pv[i]))
                MASK_AND(0); MASK_AND(1); MASK_AND(2); MASK_AND(3); MASK_AND(4); MASK_AND(5); MASK_AND(6); MASK_AND(7);
                MASK_AND(8); MASK_AND(9); MASK_AND(10); MASK_AND(11); MASK_AND(12); MASK_AND(13); MASK_AND(14); MASK_AND(15);
#undef MASK_AND
#pragma unroll
                for (int i = 0; i < 8; ++i) { asm volatile("v_add_f32 %0, %0, %1" : "+v"(l0) : "v"(pv[2 * i])); asm volatile("v_add_f32 %0, %0, %1" : "+v"(l1) : "v"(pv[2 * i + 1])); }
            } else {
#pragma unroll
                for (int i = 0; i < 8; ++i) pv[i] = fexp2(st[j][i]);
                __builtin_amdgcn_sched_barrier(0); asm volatile("s_nop 0");
#pragma unroll
                for (int i = 0; i < 4; ++i) { asm volatile("v_add_f32 %0, %0, %1" : "+v"(l0) : "v"(pv[2 * i])); asm volatile("v_add_f32 %0, %0, %1" : "+v"(l1) : "v"(pv[2 * i + 1])); }
#pragma unroll
                for (int i = 8; i < 16; ++i) pv[i] = fexp2(st[j][i]);
                __builtin_amdgcn_sched_barrier(0); asm volatile("s_nop 0");
#pragma unroll
                for (int i = 4; i < 8; ++i) { asm volatile("v_add_f32 %0, %0, %1" : "+v"(l0) : "v"(pv[2 * i])); asm volatile("v_add_f32 %0, %0, %1" : "+v"(l1) : "v"(pv[2 * i + 1])); }
            }
            bf16x8 pf[2];
#pragma unroll
            for (int s2 = 0; s2 < 2; ++s2) { f32x8 t8;
#pragma unroll
                for (int jj = 0; jj < 8; ++jj) t8[jj] = pv[8 * s2 + jj];
                pf[s2] = __builtin_convertvector(t8, bf16x8); }
#pragma unroll
            for (int d = 0; d < DV / 32; ++d)
#pragma unroll
                for (int s2 = 0; s2 < 2; ++s2) o[d] = MFMA32(vf[j][d][s2], pf[s2], o[d]);
        }
    }
}
template <int DK, int DV, int MODE>
DI void attn_block(LAS unsigned char* lds, const bf16* Kg, int ldk, const bf16* VTg, int kb0, int kb1, const AttnWave aw, const float* gtab, const unsigned* gmask, int tid, const Params& p, int l, int b) {
    typedef AttnCfg<DK, DV> C;
    constexpr int NKL = C::NKL, NVL = C::NVL, STG = C::STG;
    static_assert(C::MSK_OFF + 32 * C::MSK_LD * 4 <= LDS_MISC, "attention LDS exceeds budget");
    const int lane = tid & 63, r = lane & 31, hh = lane >> 5;
    const int pr = (r & 0x13) | ((r & 8) >> 1) | ((r & 4) << 1);
    LAS float* ltab = (LAS float*)(lds + C::TAB_OFF); LAS unsigned* lmsk = (LAS unsigned*)(lds + C::MSK_OFF);
    if (MODE == 1) {
#pragma unroll
        for (int e = tid; e < 2048; e += 512) { const int hd = e >> 8, i = e & 255; ltab[e] = gtab[hd * 2112 + i - 192 + 2047]; }
#pragma unroll
        for (int e = tid; e < 2048; e += 512) { const int q = e >> 6, wd = e & 63; lmsk[q * C::MSK_LD + wd] = gmask[(size_t)q * 64 + wd]; }
    } else if (MODE == 2) {
        if (tid < 256) { int d = 192 - tid; d = d < -128 ? -128 : (d > 128 ? 128 : d); ltab[tid] = gtab[d + 128]; }
    }
    bf16x8 qf[DK / 16];
#pragma unroll
    for (int s = 0; s < DK / 16; ++s) qf[s] = *(const bf16x8*)(aw.Q + (size_t)r * aw.ldq + 16 * s + 8 * hh);
    const float* kstat = (const float*)(p.ws + OFF_STATK) + (size_t)l * T * 4 + (size_t)b * S * 4 + aw.hd;
    if constexpr (MODE != 0) {
        const float* gq_ = (MODE == 1 ? p.b_q_gain : p.d_q_gain) + l * 64;
        float ssq = 0.f;
#pragma unroll
        for (int s = 0; s < 4; ++s)
#pragma unroll
            for (int j = 0; j < 8; ++j) { const float x = (float)qf[s][j]; ssq += x * x; }
        ssq = xhalf_sum(ssq);
        const float rq = frsq(ssq * (1.f / 64.f) + EPS) * SCALE_64;
#pragma unroll
        for (int s = 0; s < 4; ++s) { const f32x4 ga = *(const f32x4*)(gq_ + 16 * s + 8 * hh), gb = *(const f32x4*)(gq_ + 16 * s + 8 * hh + 4); float x[8];
#pragma unroll
            for (int j = 0; j < 4; ++j) { x[j] = (float)qf[s][j] * rq * ga[j]; x[4 + j] = (float)qf[s][4 + j] * rq * gb[j]; }
            qf[s] = cvt8(x); }
    }
    if constexpr (MODE == 0) {
        const size_t tq_ = (size_t)b * S + aw.s0 + r;
        const float rq = frsq(((const float*)(p.ws + OFF_STATQ))[(size_t)l * T * 4 + tq_ * 4 + aw.hd] * (1.f / 192.f) + EPS) * SCALE_192;
#pragma unroll
        for (int s = 0; s < 8; ++s) { float x[8];
#pragma unroll
            for (int j = 0; j < 8; ++j) x[j] = (float)qf[s][j] * rq;
            qf[s] = cvt8(x); }
        const float* cs_ = (const float*)(p.ws + OFF_COS) + (size_t)(aw.s0 + r) * 32; const float* sn_ = (const float*)(p.ws + OFF_SIN) + (size_t)(aw.s0 + r) * 32;
#pragma unroll
        for (int s = 8; s < 10; ++s) {
            const int i0 = 16 * (s - 8) + 8 * hh;
            const f32x4 ca = *(const f32x4*)(cs_ + i0), cb = *(const f32x4*)(cs_ + i0 + 4), sa = *(const f32x4*)(sn_ + i0), sb = *(const f32x4*)(sn_ + i0 + 4);
            float xa[8], xb[8];
#pragma unroll
            for (int j = 0; j < 8; ++j) { const float a = (float)qf[s][j] * rq, bq = (float)qf[s + 2][j] * rq;
                const float c = j < 4 ? ca[j & 3] : cb[j & 3], sv = j < 4 ? sa[j & 3] : sb[j & 3];
                xa[j] = a * c - bq * sv; xb[j] = bq * c + a * sv; }
            qf[s] = cvt8(xa); qf[s + 2] = cvt8(xb);
        }
    }
    f32x16 o[DV / 32];
#pragma unroll
    for (int d = 0; d < DV / 32; ++d)
#pragma unroll
        for (int i = 0; i < 16; ++i) o[d][i] = 0.f;
    float m_run = 0.f, l0 = 0.f, l1 = 0.f;
    const float bfar = (MODE == 1) ? gtab[aw.hd * 2112] : (MODE == 2 ? gtab[256] : 0.f);
    const LAS float* wtab = ltab + (MODE == 1 ? aw.hd * 256 : 0);
    f32x16 bmv;
#pragma unroll
    for (int i = 0; i < 16; ++i) bmv[i] = bfar;
    unsigned kgo[NKL], vgo[NVL]; int kl[NKL], vl[NVL];
#pragma unroll
    for (int i = 0; i < NKL; ++i) { const int c = tid + 512 * i, row = c / C::CPR, ch = c % C::CPR; kgo[i] = (unsigned)(row * ldk + ch * 8) * 2u; kl[i] = row * C::KST + ch * 16; }
#pragma unroll
    for (int i = 0; i < NVL; ++i) { const int c = tid + 512 * i, d = c >> 3, ch = c & 7; vgo[i] = (unsigned)(d * T + ch * 8) * 2u; vl[i] = C::KBYTES + d * C::VST + ch * 16; }
    u32x4 krA[NKL], vrA[NVL]; float skA = 0.f;
#define AT_LOAD(KR, VR, kk) do { const char* kbase_ = (const char*)(Kg + (size_t)(kk) * ldk); const char* vbase_ = (const char*)(VTg + (kk)); \
        _Pragma("unroll") for (int i = 0; i < NKL; ++i) KR[i] = *(const u32x4*)(kbase_ + kgo[i]); \
        _Pragma("unroll") for (int i = 0; i < NVL; ++i) VR[i] = *(const u32x4*)(vbase_ + vgo[i]); \
        if (MODE == 0 && tid < 64) skA = kstat[(size_t)((kk) + tid) * 4]; } while (0)
#define AT_WRITE(KR, VR, boff) do { \
        _Pragma("unroll") for (int i = 0; i < NKL; ++i) *(LAS u32x4*)(lds + (boff) + kl[i]) = KR[i]; \
        _Pragma("unroll") for (int i = 0; i < NVL; ++i) *(LAS u32x4*)(lds + (boff) + vl[i]) = VR[i]; \
        if (MODE == 0 && tid < 64) *(LAS float*)(lds + (boff) + C::KBYTES + C::VBYTES + tid * 4) = frsq(skA * (1.f / 192.f) + EPS); } while (0)
    const int klast = kb1 - 64;
    AT_LOAD(krA, vrA, kb0);
    AT_WRITE(krA, vrA, 0);
#pragma unroll
    for (int s = 0; s < DK / 16; ++s) asm volatile("" :: "v"(qf[s]));
    asm volatile("" :: "v"(bfar));
    __syncthreads();
    int cur = 0;
    for (int k0 = kb0; k0 < kb1; k0 += 64) {
        AT_LOAD(krA, vrA, (k0 + 64 < klast ? k0 + 64 : klast));
        attn_stage<DK, DV, MODE>(lds + cur * STG, k0, aw, qf, o, m_run, l0, l1, bmv, bfar, wtab, lmsk, r, hh, pr);
        AT_WRITE(krA, vrA, (cur ^ 1) * STG);
        __syncthreads();
        cur ^= 1;
    }
#undef AT_LOAD
#undef AT_WRITE
    const float lt = xhalf_sum(l0 + l1), inv = frcp(lt);
    bf16x4 zv[DV / 32][4];
#pragma unroll
    for (int d = 0; d < DV / 32; ++d)
#pragma unroll
        for (int g = 0; g < 4; ++g) zv[d][g] = *(const bf16x4*)(aw.Z + (size_t)r * LDH + 32 * d + 8 * g + 4 * hh);
#pragma unroll
    for (int d = 0; d < DV / 32; ++d)
#pragma unroll
        for (int g = 0; g < 4; ++g) {
            const int dd = 32 * d + 8 * g + 4 * hh;
            f32x4 ov;
#pragma unroll
            for (int e = 0; e < 4; ++e) ov[e] = o[d][4 * g + e] * inv * silu_f((float)zv[d][g][e]);
            *(bf16x4*)(aw.Y + (size_t)r * DM + dd) = __builtin_convertvector(ov, bf16x4);
        }
}

DI void avnorm_item(const Params& p, int item, LAS float* ls, int tid) {
    const int tb = item * 128, c = tid & 15, frow = tid >> 4, w = tid >> 6;
    const bf16* src = (const bf16*)(p.ws + OFF_VT) + (size_t)(VT_AV + frow) * T + tb + c * 8;
    float acc[8];
#pragma unroll
    for (int j = 0; j < 8; ++j) acc[j] = 0.f;
#pragma unroll
    for (int i = 0; i < 16; ++i) { const bf16x8 v = *(const bf16x8*)(src + (size_t)(32 * i) * T);
#pragma unroll
        for (int j = 0; j < 8; ++j) { const float f = (float)v[j]; acc[j] += f * f; } }
#pragma unroll
    for (int j = 0; j < 8; ++j) { acc[j] = xrow_sum(acc[j]); acc[j] = xhalf_sum(acc[j]); }
    if ((tid & 63) < 16) {
#pragma unroll
        for (int j = 0; j < 8; ++j) ls[w * 128 + c * 8 + j] = acc[j];
    }
    __syncthreads();
    if (tid < 128) { float sum = 0.f;
#pragma unroll
        for (int k = 0; k < 8; ++k) sum += ls[k * 128 + tid];
        ((float*)(p.ws + OFF_SSV))[tb + tid] = frsq(sum * (1.f / 512.f) + EPS); }
    __syncthreads();
}
DI void mixA_item(const Params& p, int l, int item, int tid) {
    const int w = __builtin_amdgcn_readfirstlane(tid >> 6), lane = tid & 63, r = lane & 31, hh = lane >> 5;
    const int g = item & 3, n = (item >> 2) & 15, b = item >> 6, tb = b * S + n * 128;
    const int it = w >> 1, cp = w & 1;
    const bf16* Wa = (const bf16*)(p.ws + OFF_WA) + (size_t)(l * 4 + g) * 128 * 128;
    const bf16* gvT = (const bf16*)(p.ws + OFF_VT); const float* rstd = (const float*)(p.ws + OFF_SSV) + tb;
    const bf16* hb = (const bf16*)(p.ws + OFF_H); bf16* y = (bf16*)(p.ws + OFF_U3);
    f32x16 acc[2];
#pragma unroll
    for (int c = 0; c < 2; ++c)
#pragma unroll
        for (int i = 0; i < 16; ++i) acc[c][i] = 0.f;
    bf16x8 wf[8], raw[2][8]; f32x4 rs0[8], rs1[8]; float gn[2];
#pragma unroll
    for (int ci = 0; ci < 2; ++ci) gn[ci] = p.a_v_gain[l * 512 + g * 128 + (2 * cp + ci) * 32 + r];
#pragma unroll
    for (int s = 0; s < 8; ++s) {
        wf[s] = *(const bf16x8*)(Wa + (size_t)(it * 32 + r) * 128 + s * 16 + hh * 8);
        rs0[s] = *(const f32x4*)(rstd + s * 16 + hh * 8); rs1[s] = *(const f32x4*)(rstd + s * 16 + hh * 8 + 4);
#pragma unroll
        for (int ci = 0; ci < 2; ++ci) raw[ci][s] = *(const bf16x8*)(gvT + (size_t)(VT_AV + g * 128 + (2 * cp + ci) * 32 + r) * T + tb + s * 16 + hh * 8);
    }
#pragma unroll
    for (int s = 0; s < 8; ++s) {
        if (s < 4 || it >= 2) {
#pragma unroll
            for (int ci = 0; ci < 2; ++ci) {
                float bv[8];
#pragma unroll
                for (int j = 0; j < 4; ++j) { bv[j] = (float)raw[ci][s][j] * rs0[s][j] * gn[ci]; bv[4 + j] = (float)raw[ci][s][4 + j] * rs1[s][j] * gn[ci]; }
                acc[ci] = MFMA32(cvt8(bv), wf[s], acc[ci]);
            }
        }
    }
    const size_t t = (size_t)tb + it * 32 + r;
    const float bs = p.a_bs[(size_t)(l * 4 + g) * 128 + it * 32 + r];
    bf16x4 uv[2][4], zv[2][4];
#pragma unroll
    for (int ci = 0; ci < 2; ++ci)
#pragma unroll
        for (int g4 = 0; g4 < 4; ++g4) { const int col = g * 128 + (2 * cp + ci) * 32 + 8 * g4 + 4 * hh;
            uv[ci][g4] = *(const bf16x4*)(hb + t * LDH + H_AU + col); zv[ci][g4] = *(const bf16x4*)(hb + t * LDH + H_AZ + col); }
#pragma unroll
    for (int ci = 0; ci < 2; ++ci)
#pragma unroll
        for (int g4 = 0; g4 < 4; ++g4) {
            const int col = g * 128 + (2 * cp + ci) * 32 + 8 * g4 + 4 * hh;
            f32x4 ov;
#pragma unroll
            for (int e = 0; e < 4; ++e) ov[e] = gelu_t((float)uv[ci][g4][e]) * (acc[ci][4 * g4 + e] + bs) * silu_f((float)zv[ci][g4][e]);
            *(bf16x4*)(y + t * DM + col) = __builtin_convertvector(ov, bf16x4);
        }
}

DI void phase_mix(const Params& p, int l, int G, LAS unsigned char* lds, int wv) {
    const int tid = opaque_tid(wv), w = __builtin_amdgcn_readfirstlane(tid >> 6);
    const bf16* hb = (const bf16*)(p.ws + OFF_H); bf16* y = (bf16*)(p.ws + OFF_U3);
    const bf16* vT = (const bf16*)(p.ws + OFF_VT);
    unsigned* ctr = (unsigned*)(p.ws + OFF_CTL) + XB_CTR(l);
    volatile LAS unsigned* bc = (volatile LAS unsigned*)(lds + LDS_MISC) + 4;
    for (;;) {
        if (tid == 0) *bc = xb_add(ctr, 1u);
        __syncthreads();
        const int item = (int)*bc;
        __syncthreads();
        if (item >= 1792) break;
        int tq = tid; asm volatile("" : "+v"(tq));
        if (item < 256) {
            const int qb = 7 - (item >> 5), bh = item & 31, b = bh >> 2, hd = bh & 3, s0 = qb * 256 + 32 * w; const size_t t0 = (size_t)b * S + s0;
            AttnWave aw{(const bf16*)(p.ws + OFF_QC) + t0 * 768 + hd * 192, 768, hb + t0 * LDH + H_CZ + hd * 128, y + t0 * DM + 1024 + hd * 128, s0, 0, ((s0 >> 6) + 1) * 64, hd};
            attn_block<192, 128, 0>(lds, (const bf16*)(p.ws + OFF_KC) + (size_t)b * S * 768 + hd * 192, 768, (const bf16*)(p.ws + OFF_VCT) + (size_t)(hd * 128) * T + (size_t)b * S,
                                    0, (qb + 1) * 256, aw, nullptr, nullptr, tq, p, l, b);
        } else if (item < 768) {
            const int j = item - 256, qt = 63 - (j >> 3), b = j & 7, s0 = qt * 32, hd = w; const size_t t0 = (size_t)b * S + s0;
            AttnWave aw{hb + t0 * LDH + H_BQ + hd * 64, LDH, hb + t0 * LDH + H_BZ + hd * 64, y + t0 * DM + 512 + hd * 64, s0, 0, ((s0 >> 6) + 1) * 64, hd};
            attn_block<64, 64, 1>(lds, hb + (size_t)b * S * LDH + H_BK, LDH, vT + (size_t)VT_BV * T + (size_t)b * S, 0, ((s0 >> 6) + 1) * 64, aw,
                                  (const float*)(p.ws + OFF_T5), (const unsigned*)(p.ws + OFF_MASK) + t0 * 64, tq, p, l, b);
        } else if (item < 1280) {
            const int j = item - 768, qb = 7 - (j >> 6), bh = j & 63, b = bh >> 3, hd = bh & 7, s0 = qb * 256 + 32 * w, c = s0 >> 6; const size_t t0 = (size_t)b * S + s0;
            AttnWave aw{hb + t0 * LDH + H_DQ + hd * 64, LDH, hb + t0 * LDH + H_DZ + hd * 64, y + t0 * DM + 1536 + hd * 64, s0, (c > 8 ? c - 8 : 0) * 64, (c + 1) * 64, hd};
            const int c0 = qb * 4;
            attn_block<64, 64, 2>(lds, hb + (size_t)b * S * LDH + H_DK + hd * 64, LDH, vT + (size_t)(VT_DV + hd * 64) * T + (size_t)b * S, (c0 > 8 ? c0 - 8 : 0) * 64, (c0 + 4) * 64, aw,
                                  (const float*)(p.ws + OFF_DT) + (size_t)l * 8 * 264 + hd * 264, nullptr, tq, p, l, b);
        } else {
            mixA_item(p, l, item - 1280, tq);
        }
    }
}

DI void phase_select_post1(const Params& p, int l, int G, LAS unsigned char* lds, int wv) {
    const int tid = opaque_tid(wv), blk = blockIdx.x, w = __builtin_amdgcn_readfirstlane(tid >> 6), lane = tid & 63;
    const bf16* hb = (const bf16*)(p.ws + OFF_H); unsigned* mask = (unsigned*)(p.ws + OFF_MASK);
    unsigned* ctr = (unsigned*)(p.ws + OFF_CTL) + XB_CTR(2 + l);
    volatile LAS unsigned* bc = (volatile LAS unsigned*)(lds + LDS_MISC) + 4;
    const int fr = lane & 15, fq = lane >> 4;
    SelRegs R;
    if (tid == 0) *bc = xb_add(ctr, 1u);
    __syncthreads();
    int j = (int)*bc;
    __syncthreads();
    if (j < 1024) sel_load(R, hb, j & 7, 127 - (j >> 3), w, fr, fq);
    while (j < 1024) {
        if (tid == 0) *bc = xb_add(ctr, 1u);
        {
            const int b = j & 7, qg = 127 - (j >> 3);
            if (qg >= 16) sel_scores(R, hb, b, qg, (LAS float*)lds, w, fr, fq);
            __syncthreads();
            const int jn = (int)*bc;
            if (jn < 1024) sel_load(R, hb, jn & 7, 127 - (jn >> 3), w, fr, fq);
            sel_select(mask, b, qg, (LAS float*)lds, w, lane);
            __syncthreads();
            j = jn;
        }
    }
    while (j < 1408) {
        if (tid == 0) *bc = xb_add(ctr, 1u);
        {
            if (j < 1152) avnorm_item(p, j - 1024, (LAS float*)lds, tid);
            else { const int r0 = (j - 1152) * 64 + w * 8;
                int lq = lane; asm volatile("" : "+v"(lq));
                P1Gains pg; pg.sk = (float*)(p.ws + OFF_STATK) + (size_t)l * T * 4; { const int d0 = (lq & 7) * 8;
#pragma unroll
        for (int j = 0; j < 8; ++j) { pg.bq[j] = p.b_q_gain[l * 64 + d0 + j]; pg.dq[j] = p.d_q_gain[l * 64 + d0 + j]; pg.dk[j] = p.d_k_gain[l * 64 + d0 + j]; pg.bk[j] = p.b_k_gain[l * 64 + d0 + j]; pg.kr[j] = p.c_k_gain[l * 192 + 128 + d0 + j]; } }
#pragma unroll 1
                for (int i = 0; i < 8; i += 4) { const int tt[4] = {r0 + i, r0 + i + 1, r0 + i + 2, r0 + i + 3}; post1_rows<4>(p, pg, tt, lq); } }
            __syncthreads();
            const int jn = (int)*bc;
            __syncthreads();
            j = jn;
        }
    }
}
__global__ void __launch_bounds__(512, 2) fwd_mega(Params p) {
    extern __shared__ __attribute__((aligned(16))) unsigned char lds_raw[];
    LAS unsigned char* lds = (LAS unsigned char*)lds_raw;
    cg::grid_group grid = cg::this_grid();
    const int G = gridDim.x, blk = blockIdx.x;
    const int wv = __builtin_amdgcn_readfirstlane(threadIdx.x >> 6);
    volatile LAS unsigned* misc = (volatile LAS unsigned*)(lds + LDS_MISC);
    if (threadIdx.x < 8) misc[threadIdx.x] = 0u;
    __syncthreads();
    XcdBarrier bar = xcd_barrier_post((unsigned*)(p.ws + OFF_CTL), misc, threadIdx.x == 0);
#define SEAM() xcd_barrier(bar, wv)
    phase_prep(p, lds, G, wv);
    if (G > (1 << 24)) grid.sync();
    SEAM();
#pragma unroll 1
    for (int l = 0; l < 2; ++l) {
        {
            Sched1 S1{blk, G, 64 + 26 * l, l == 0 ? 1664 : 1536};
            Epi1 E1{(bf16*)(p.ws + OFF_H), (bf16*)(p.ws + OFF_U2), (bf16*)(p.ws + OFF_VT), 64 + 26 * l, (float*)(p.ws + OFF_STATL) + (size_t)l * T * 2, (const float*)(p.ws + OFF_STATX) + (size_t)l * T};
            pg8::Gemm g1{(const pg8::bf16_t*)(p.ws + OFF_U1), (const pg8::bf16_t*)(p.ws + OFF_U1), 2048};
            pg8::gemm_phase<Epi1, Sched1, G_ALIGN, G_SP2>(lds, g1, S1, E1, wv);
            if (l == 1) { Sched1H S1h{blk, G, 64 + 26 * l}; pg8::gemm_phase<Epi1, Sched1H, G_ALIGN, G_SP2, true>(lds, g1, S1h, E1, wv); }
            if (l == 0) { int Gq = G; asm volatile("" : "+s"(Gq));
                const int nfull = 1664 % Gq, nidle = Gq - nfull;
                if (nfull > 0 && blk >= nfull) prep_weights(p, 1, (LAS float*)lds, blk - nfull, nidle, opaque_tid(wv));
                else if (nfull == 0) prep_weights(p, 1, (LAS float*)lds, blk, G, opaque_tid(wv)); }
        }
        SEAM();
        {
            Sched2 S2{blk, G, 64 + 7 * l};
            Epi2 E2{(bf16*)(p.ws + OFF_QC), (bf16*)(p.ws + OFF_KC), (bf16*)(p.ws + OFF_VCT), (const float*)(p.ws + OFF_STATL) + (size_t)l * T * 2, 64 + 7 * l, (float*)(p.ws + OFF_STATK) + (size_t)l * T * 4, (float*)(p.ws + OFF_STATQ) + (size_t)l * T * 4, p.c_q_gain + l * 192, p.c_k_gain + l * 192};
            pg8::Gemm g2{(const pg8::bf16_t*)(p.ws + OFF_U2), (const pg8::bf16_t*)(p.ws + OFF_U2), 512};
            pg8::gemm_phase<Epi2, Sched2, G_ALIGN, G_SP2>(lds, g2, S2, E2, wv);
        }
        phase_select_post1(p, l, G, lds, wv);
        SEAM();
        phase_mix(p, l, G, lds, wv);
        SEAM();
        {
            Sched3 S3{blk, G, 64 + 8 * l};
            pg8::Gemm g3{(const pg8::bf16_t*)(p.ws + OFF_U3), (const pg8::bf16_t*)(p.ws + OFF_U3), 2048};
            if (l == 0) { Epi3<true> E3{p.x, nullptr, nullptr, (bf16*)(p.ws + OFF_U1), (float*)(p.ws + OFF_STATX) + T, 64 + 8 * l};
                pg8::gemm_phase<Epi3<true>, Sched3, G_ALIGN, G_SP2>(lds, g3, S3, E3, wv); }
            else { Epi3<false> E3{nullptr, (const bf16*)(p.ws + OFF_U1), p.out, nullptr, nullptr, 64 + 8 * l};
                pg8::gemm_phase<Epi3<false>, Sched3, G_ALIGN, G_SP2>(lds, g3, S3, E3, wv); }
        }
        if (l == 0) SEAM();
    }
}

extern "C" void kernel_launch(void* const* d_in, const int* in_sizes, int n_in, void* d_out, int out_size, void* d_ws, size_t ws_size, hipStream_t stream) {
    static int grid_blocks = 0;
    if (!grid_blocks) {
        int dev = 0, cus = 0, per_cu = 0;
        hipGetDevice(&dev);
        hipDeviceGetAttribute(&cus, hipDeviceAttributeMultiprocessorCount, dev);
        hipFuncSetAttribute((const void*)fwd_mega, hipFuncAttributeMaxDynamicSharedMemorySize, (int)LDS_BYTES);
        hipOccupancyMaxActiveBlocksPerMultiprocessor(&per_cu, fwd_mega, 512, LDS_BYTES);
        if (per_cu > 1) per_cu = 1;
        grid_blocks = cus * per_cu;
        if (grid_blocks <= 0 || ws_size < WS_NEED) fprintf(stderr, "bad config: grid %d ws %zu need %zu\n", grid_blocks, ws_size, (size_t)WS_NEED);
    }
    Params p{};
    p.x = (const float*)d_in[0]; p.t5_bias = (const float*)d_in[1]; p.norm_g = (const float*)d_in[2]; p.w_in = (const float*)d_in[3];
    p.a_v_gain = (const float*)d_in[4]; p.a_ws = (const float*)d_in[5]; p.a_bs = (const float*)d_in[6]; p.b_q_gain = (const float*)d_in[7];
    p.b_k_gain = (const float*)d_in[8]; p.c_qa_gain = (const float*)d_in[9]; p.c_kva_gain = (const float*)d_in[10]; p.c_w_qb = (const float*)d_in[11];
    p.c_w_kvb = (const float*)d_in[12]; p.c_q_gain = (const float*)d_in[13]; p.c_k_gain = (const float*)d_in[14]; p.d_q_gain = (const float*)d_in[15];
    p.d_k_gain = (const float*)d_in[16]; p.d_rel_bias = (const float*)d_in[17]; p.w_out = (const float*)d_in[18];
    p.out = (float*)d_out; p.ws = (unsigned char*)d_ws;
    hipMemsetAsync((unsigned char*)d_ws + OFF_CTL, 0, CTL_BYTES, stream);
    void* args[] = {&p};
    hipError_t e = hipLaunchCooperativeKernel((void*)fwd_mega, dim3(grid_blocks), dim3(512), args, LDS_BYTES, stream);
    if (e != hipSuccess) fprintf(stderr, "cooperative launch failed: %s (grid %d)\n", hipGetErrorString(e), grid_blocks);
}
```

```cpp
#include <hip/hip_runtime.h>
#include <hip/hip_cooperative_groups.h>
#include <cstdio>
#include <cstdint>
namespace cg = cooperative_groups;

#define G_ALIGN true
#define G_SP2 true
#define DI __device__ __forceinline__
#define LAS __attribute__((address_space(3)))
typedef __bf16 bf16;
typedef __bf16 bf16x8 __attribute__((ext_vector_type(8)));
typedef __bf16 bf16x4 __attribute__((ext_vector_type(4)));
typedef float f32x4 __attribute__((ext_vector_type(4)));
typedef float f32x8 __attribute__((ext_vector_type(8)));
typedef float f32x16 __attribute__((ext_vector_type(16)));
typedef unsigned u32x4 __attribute__((ext_vector_type(4)));
typedef unsigned u32x2 __attribute__((ext_vector_type(2)));

constexpr int T = 16384, S = 2048, NBATCH = 8, DM = 2048, INC = 6408;
constexpr int LDH = 4864;
constexpr int H_AU = 0, H_AZ = 512, H_BQ = 1024, H_BIQ = 1536, H_BZ = 2048, H_CZ = 2560, H_DQ = 3072, H_DK = 3584, H_DZ = 4096,
              H_BK = 4608, H_BIK = 4672, H_CKR = 4736, H_BIW = 4800;
constexpr int VT_AV = 0, VT_DV = 512, VT_BV = 1024;
constexpr float EPS = 1e-6f, LOG2E = 1.4426950408889634f;
constexpr float SCALE_64 = 0.125f * LOG2E;
constexpr float SCALE_192 = 0.07216878364870322f * LOG2E;
constexpr float C_IW = 0.04419417382415922f;
constexpr int SCLD = 2052;
constexpr int LDS_MISC = 16 * SCLD * 4;
constexpr size_t LDS_BYTES = LDS_MISC + 256;

constexpr size_t MiB = 1048576;
constexpr size_t OFF_U1 = 0;
constexpr size_t OFF_U2 = OFF_U1 + 116 * MiB;
constexpr size_t OFF_U3 = OFF_U2 + 78 * (MiB / 4);
constexpr size_t OFF_H = OFF_U3 + 80 * MiB;
constexpr size_t OFF_VT = OFF_H + (size_t)T * LDH * 2;
constexpr size_t OFF_QC = OFF_VT + (size_t)1280 * T * 2;
constexpr size_t OFF_KC = OFF_QC + (size_t)T * 768 * 2;
constexpr size_t OFF_VCT = OFF_KC + (size_t)T * 768 * 2;
constexpr size_t OFF_MASK = OFF_VCT + (size_t)512 * T * 2;
constexpr size_t OFF_STATS = OFF_MASK + (size_t)T * 64 * 4;
constexpr size_t OFF_SSV = OFF_STATS + (size_t)T * 2 * 4;
constexpr size_t OFF_WA = OFF_SSV + (size_t)T * 4;
constexpr size_t OFF_COS = OFF_WA + 2 * 4 * 128 * 128 * 2;
constexpr size_t OFF_SIN = OFF_COS + 2048 * 32 * 4;
constexpr size_t OFF_T5 = OFF_SIN + 2048 * 32 * 4;
constexpr size_t OFF_DT = OFF_T5 + 8 * 2112 * 4;
constexpr size_t OFF_CTL = OFF_DT + 2 * 8 * 264 * 4;
constexpr size_t CTL_BYTES = 16384;
constexpr size_t OFF_STATK = OFF_CTL + CTL_BYTES;
constexpr size_t OFF_STATL = OFF_STATK + (size_t)2 * T * 4 * 4;
constexpr size_t OFF_STATX = OFF_STATL + (size_t)2 * T * 2 * 4;
constexpr size_t OFF_STATQ = OFF_STATX + (size_t)2 * T * 4;
constexpr size_t WS_NEED = OFF_STATQ + (size_t)2 * T * 4 * 4;

struct Params {
    const float* x; const float* t5_bias; const float* norm_g; const float* w_in; const float* a_v_gain; const float* a_ws; const float* a_bs;
    const float* b_q_gain; const float* b_k_gain; const float* c_qa_gain; const float* c_kva_gain; const float* c_w_qb; const float* c_w_kvb;
    const float* c_q_gain; const float* c_k_gain; const float* d_q_gain; const float* d_k_gain; const float* d_rel_bias; const float* w_out;
    float* out; unsigned char* ws;
};

DI int lane_id() { int t; asm volatile("v_mbcnt_lo_u32_b32 %0, -1, 0\n\tv_mbcnt_hi_u32_b32 %0, -1, %0" : "=v"(t)); return t; }
DI int opaque_tid(int wv) { return (wv << 6) | lane_id(); }
DI float fexp2(float x) { return __builtin_amdgcn_exp2f(x); }
DI float frcp(float x) { return __builtin_amdgcn_rcpf(x); }
DI float frsq(float x) { return __builtin_amdgcn_rsqf(x); }
DI float gelu_t(float x) { const float a = 0.7978845608028654f * (x + 0.044715f * x * x * x); return x * frcp(1.f + fexp2(-2.f * LOG2E * a)); }
DI float silu_f(float z) { return z * frcp(1.f + fexp2(-LOG2E * z)); }
DI bf16x8 cvt8(const float (&v)[8]) { f32x8 t; for (int j = 0; j < 8; ++j) t[j] = v[j]; return __builtin_convertvector(t, bf16x8); }
DI float shx(float v, int m) { return __shfl_xor(v, m); }
template <int CTRL> DI float dppf(float v) { return __int_as_float(__builtin_amdgcn_update_dpp(0, __float_as_int(v), CTRL, 0xF, 0xF, true)); }
#define DPP_XOR1 0xB1
#define DPP_XOR2 0x4E
#define DPP_XOR8 0x128
DI float dpp_xor4(float v) {
    int r = __builtin_amdgcn_update_dpp(0, __float_as_int(v), 0x104, 0xF, 0x5, false);
    r = __builtin_amdgcn_update_dpp(r, __float_as_int(v), 0x114, 0xF, 0xA, false);
    return __int_as_float(r); }
DI float sum8(float s) { s += dppf<DPP_XOR1>(s); s += dppf<DPP_XOR2>(s); s += dpp_xor4(s); return s; }
DI float xrow_sum(float x) { auto r = __builtin_amdgcn_permlane16_swap(__float_as_uint(x), __float_as_uint(x), false, false); return __uint_as_float(r[0]) + __uint_as_float(r[1]); }
DI float xhalf_max(float x) { auto r = __builtin_amdgcn_permlane32_swap(__float_as_uint(x), __float_as_uint(x), false, false); return fmaxf(__uint_as_float(r[0]), __uint_as_float(r[1])); }
DI float xhalf_sum(float x) { auto r = __builtin_amdgcn_permlane32_swap(__float_as_uint(x), __float_as_uint(x), false, false); return __uint_as_float(r[0]) + __uint_as_float(r[1]); }
DI float relu_i(float x) { const int b = __float_as_int(x); return __int_as_float(b > 0 ? b : 0); }
DI int crow(int reg, int h) { return (reg & 3) + 8 * (reg >> 2) + 4 * h; }
#define MFMA32(a, b, c) __builtin_amdgcn_mfma_f32_32x32x16_bf16((a), (b), (c), 0, 0, 0)
#define MFMA16(a, b, c) __builtin_amdgcn_mfma_f32_16x16x32_bf16((a), (b), (c), 0, 0, 0)


#define XB_TMO      128
#define XB_XCNT(j)  (256  + 64 * (j))
#define XB_XSUB(j)  (1280 + 64 * (j))
#define XB_XGEN(j)  (2304 + 64 * (j))
#define XB_TOP      3328
#define XB_TOPGEN   3392
#define XCD_BAR_WORDS 3456
#define XB_CTR(j)   (3520 + 64 * (j))
#define XB_SPIN_CAP (1u << 18)
DI unsigned xb_ld(unsigned* p)              { return __hip_atomic_load(p, __ATOMIC_RELAXED, __HIP_MEMORY_SCOPE_AGENT); }
DI unsigned xb_add(unsigned* p, unsigned v) { return __hip_atomic_fetch_add(p, v, __ATOMIC_RELAXED, __HIP_MEMORY_SCOPE_AGENT); }
DI unsigned xb_xcc_id() { return (unsigned)__builtin_amdgcn_s_getreg((3 << 11) | 20) & 0xFu; }
#define XB_SPIN(cond, bar) do { unsigned _sp = 0; while (cond) { __builtin_amdgcn_s_sleep(1); \
    if ((++_sp & 255u) == 0u) { if (xb_ld(&(bar)[XB_TMO])) break; if (_sp > XB_SPIN_CAP) { atomicAdd(&(bar)[XB_TMO], 1u); break; } } } } while (0)
struct XcdBarrier { unsigned* bar; unsigned x; volatile LAS unsigned* st; };
DI XcdBarrier xcd_barrier_post(unsigned* bar, volatile LAS unsigned* st, bool leader) {
    XcdBarrier b; b.bar = bar; b.x = xb_xcc_id(); b.st = st;
    if (leader) (void)xb_add(&bar[XB_XCNT(b.x)], 1u);
    return b;
}
DI void xcd_barrier_complete(unsigned* bar, unsigned x, unsigned& nloc, unsigned& nx) {
    const unsigned G = gridDim.x * gridDim.y * gridDim.z;
    unsigned sum, cnt, mine, sp = 0u;
    for (;;) {
        sum = 0u; cnt = 0u; mine = 0u;
#pragma unroll
        for (unsigned j = 0; j < 16; ++j) { const unsigned c = xb_ld(&bar[XB_XCNT(j)]); sum += c; cnt += (c > 0u) ? 1u : 0u; mine = (j == x) ? c : mine; }
        if (sum == G) break;
        __builtin_amdgcn_s_sleep(1);
        if ((++sp & 255u) == 0u) { if (xb_ld(&bar[XB_TMO])) break; if (sp > XB_SPIN_CAP) { atomicAdd(&bar[XB_TMO], 1u); break; } }
    }
    nloc = mine > 0u ? mine : 1u; nx = cnt > 0u ? cnt : 1u;
}
DI void xcd_barrier(const XcdBarrier& b, int wv) {
    asm volatile("s_waitcnt vmcnt(0)" ::: "memory");
    __syncthreads();
    if (wv == 0 && lane_id() == 0) {
        unsigned* bar = b.bar;
        unsigned bx = b.x; asm volatile("" : "+s"(bx));
        __builtin_amdgcn_s_waitcnt(0);
        unsigned nloc = b.st[0], nx = b.st[1];
        if (nloc == 0u) { xcd_barrier_complete(bar, bx, nloc, nx); b.st[0] = nloc; b.st[1] = nx; }
        const unsigned old = xb_add(&bar[XB_XSUB(bx)], 1u);
        const unsigned gen = old / nloc;
        if (old + 1u == (gen + 1u) * nloc) {
            __builtin_amdgcn_fence(__ATOMIC_RELEASE, "agent");
            asm volatile("s_waitcnt vmcnt(0)" ::: "memory");
            const unsigned og = xb_add(&bar[XB_TOP], 1u);
            const unsigned tg = og / nx;
            if (og + 1u == (tg + 1u) * nx) xb_add(&bar[XB_TOPGEN], 1u);
            else XB_SPIN(xb_ld(&bar[XB_TOPGEN]) == tg, bar);
            __builtin_amdgcn_fence(__ATOMIC_ACQUIRE, "agent");
            xb_add(&bar[XB_XGEN(bx)], 1u);
            asm volatile("s_waitcnt vmcnt(0)" ::: "memory");
        } else {
            XB_SPIN(xb_ld(&bar[XB_XGEN(bx)]) == gen, bar);
            __builtin_amdgcn_fence(__ATOMIC_ACQUIRE, "agent");
            asm volatile("s_waitcnt vmcnt(0)" ::: "memory");
        }
    }
    __syncthreads();
}

namespace pg8 {
typedef unsigned short bf16_t;
typedef short s16x8 __attribute__((ext_vector_type(8)));
constexpr int BM = 256, BK = 64, HALF = 128, HTB = HALF * BK * 2, STAGE_BYTES = 8 * HTB;
__host__ __device__ __forceinline__ int lds_byte(int r, int c) { const int st = (r >> 4) * 2 + (c >> 5), rr = r & 15, cc = c & 31, ob = rr * 64 + cc * 2; return st * 1024 + (ob ^ (((ob >> 9) & 1) << 5)); }
__host__ __device__ __forceinline__ void stage_rc(int b, int& R, int& C) { const int st = b / 1024, sb = b % 1024, swz = sb ^ (((sb >> 9) & 1) << 5); R = (st >> 1) * 16 + swz / 64; C = (st & 1) * 32 + (swz % 64) / 2; }
__host__ __device__ __forceinline__ int perm32(int rho) { const int n = rho >> 4, i = rho & 15; return 8 * (i >> 2) + 4 * n + (i & 3); }
struct Unit { int pm, pn, koff, nt, half; };
struct Gemm { const bf16_t* A; const bf16_t* Bt; int K; };

template <class Epi, class Sched, bool ALIGN_EPI = false, bool SP2 = false, bool HALFU = false>
__device__ __forceinline__ void gemm_phase(LAS unsigned char* lds, const Gemm g, const Sched& S, const Epi& E, int wv) {
    const int tid = opaque_tid(wv), wid = __builtin_amdgcn_readfirstlane(tid >> 6), lane = tid & 63, wr = wid >> 2, wc = wid & 3, fr = lane & 15, fq = lane >> 4;
    const int K = g.K;
    unsigned voffA[2], voffB[2];
#pragma unroll
    for (int i = 0; i < 2; ++i) { int R, C; stage_rc(tid * 16 + i * 8192, R, C); const int Rb = Epi::PERM ? ((R & ~31) + perm32(R & 31)) : R;
        voffA[i] = (unsigned)(R * K + C) * 2u; voffB[i] = (unsigned)(Rb * K + C) * 2u; }
    const size_t kstep = (size_t)(BK * 2);
    const size_t hstep = (size_t)HALF * K * 2;
    const size_t tstep = 2 * hstep;
    const unsigned ldsw = (unsigned)wid * 1024u;
    const int aoff = lds_byte(wr * 64 + fr, fq * 8), boff = lds_byte(wc * 32 + fr, fq * 8);
#define PG8_SA(b, h) (((b) * 2 + (h)) * HTB)
#define PG8_SB(b, h) ((4 + (b) * 2 + (h)) * HTB)
#define PG8_STAGE(bufoff, gbase, voff) do { _Pragma("unroll") for (int _i = 0; _i < 2; ++_i) \
        __builtin_amdgcn_global_load_lds((const unsigned*)((const char*)(gbase) + (voff)[_i]), (LAS unsigned*)(lds + (bufoff) + ldsw + _i * 8192), 16, 0, 0); } while (0)
#define PG8_LDA(dst, b, h) do { _Pragma("unroll") for (int m = 0; m < 4; ++m) _Pragma("unroll") for (int k = 0; k < 2; ++k) dst[m][k] = *(const LAS s16x8*)(lds + PG8_SA(b, h) + aoff + m * 2048 + k * 1024); } while (0)
#define PG8_LDB(dst, b, h) do { _Pragma("unroll") for (int n = 0; n < 2; ++n) _Pragma("unroll") for (int k = 0; k < 2; ++k) dst[n][k] = *(const LAS s16x8*)(lds + PG8_SB(b, h) + boff + n * 2048 + k * 1024); } while (0)
#define PG8_MMA(ai, bj, At, Bt) do { __builtin_amdgcn_s_setprio(1); _Pragma("unroll") for (int m = 0; m < 4; ++m) _Pragma("unroll") for (int n = 0; n < 2; ++n) _Pragma("unroll") for (int k = 0; k < 2; ++k) \
        acc[ai][bj][m][n] = __builtin_amdgcn_mfma_f32_16x16x32_bf16(Bt[n][k], At[m][k], acc[ai][bj][m][n], 0, 0, 0); __builtin_amdgcn_s_setprio(0); } while (0)
#define PG8_WAIT_V(n) asm volatile("s_waitcnt vmcnt(" #n ")" ::: "memory")
#define PG8_WAIT_L(n) asm volatile("s_waitcnt lgkmcnt(" #n ")" ::: "memory")
#define PG8_BAR __builtin_amdgcn_s_barrier()
#define PG8_SCHED __builtin_amdgcn_sched_barrier(0)
    Unit cur, nxt; int ui = 0;
    if (!S.next(0, cur)) return;
    f32x4 acc[2][2][4][2];
#pragma unroll
    for (int a = 0; a < 2; ++a)
#pragma unroll
        for (int b = 0; b < 2; ++b)
#pragma unroll
            for (int m = 0; m < 4; ++m)
#pragma unroll
                for (int n = 0; n < 2; ++n) acc[a][b][m][n] = (f32x4){0.f, 0.f, 0.f, 0.f};
    s16x8 At[4][2], B0[2][2], B1[2][2];
    const char* cA = (const char*)g.A + (size_t)cur.pm * tstep + cur.koff + (HALFU && cur.half == 2 ? hstep : 0); const char* cB = (const char*)g.Bt + (size_t)cur.pn * tstep + cur.koff;
    if constexpr (SP2) {
        PG8_STAGE(PG8_SB(0, 0), cB, voffB); PG8_STAGE(PG8_SB(0, 1), cB + hstep, voffB); PG8_STAGE(PG8_SA(0, 0), cA, voffA); PG8_STAGE(PG8_SA(0, 1), cA + hstep, voffA);
        if (wr == 1) PG8_BAR;
        PG8_WAIT_V(2); PG8_BAR;
        PG8_STAGE(PG8_SB(1, 0), cB + kstep, voffB); PG8_STAGE(PG8_SA(1, 0), cA + kstep, voffA); PG8_STAGE(PG8_SB(1, 1), cB + hstep + kstep, voffB);
        PG8_WAIT_V(6); PG8_BAR;
    } else {
        PG8_STAGE(PG8_SB(0, 0), cB, voffB); PG8_STAGE(PG8_SA(0, 0), cA, voffA); PG8_STAGE(PG8_SB(0, 1), cB + hstep, voffB); PG8_STAGE(PG8_SA(0, 1), cA + hstep, voffA);
        if (wr == 1) PG8_BAR;
        PG8_WAIT_V(4); PG8_BAR;
        PG8_STAGE(PG8_SB(1, 0), cB + kstep, voffB); PG8_STAGE(PG8_SA(1, 0), cA + kstep, voffA); PG8_STAGE(PG8_SB(1, 1), cB + hstep + kstep, voffB);
        PG8_WAIT_V(6); PG8_BAR;
    }
    for (;;) {
        const bool has_next = S.next(ui + 1, nxt);
        const char* nA = has_next ? (const char*)g.A + (size_t)nxt.pm * tstep + nxt.koff + (HALFU && nxt.half == 2 ? hstep : 0) : cA; const char* nB = has_next ? (const char*)g.Bt + (size_t)nxt.pn * tstep + nxt.koff : cB;
        const int nt = cur.nt; constexpr bool hf = HALFU;
        for (int t = 0; t < nt; t += 2) {
            const bool last = (t == nt - 2);
            const char* a1 = cA + (size_t)(t + 1) * kstep;
            const char* a2 = last ? nA : cA + (size_t)(t + 2) * kstep; const char* b2 = last ? nB : cB + (size_t)(t + 2) * kstep;
            const char* a3 = a2 + kstep; const char* b3 = b2 + kstep;
            if constexpr (SP2) {
            PG8_LDB(B0, 0, 0); PG8_LDB(B1, 0, 1); PG8_SCHED; PG8_LDA(At, 0, 0); PG8_STAGE(PG8_SA(1, 1), a1 + hstep, voffA);
            PG8_WAIT_V(8); PG8_WAIT_L(0); PG8_BAR; PG8_MMA(0, 0, At, B0); PG8_MMA(0, 1, At, B1); PG8_BAR; PG8_SCHED;
            if (!hf) PG8_LDA(At, 0, 1); PG8_STAGE(PG8_SB(0, 0), b2, voffB); PG8_STAGE(PG8_SB(0, 1), b2 + hstep, voffB); PG8_STAGE(PG8_SA(0, 0), a2, voffA);
            PG8_WAIT_V(8); PG8_WAIT_L(0); PG8_BAR; if (!hf) { PG8_MMA(1, 0, At, B0); PG8_MMA(1, 1, At, B1); } PG8_BAR; PG8_SCHED;
            PG8_LDB(B0, 1, 0); PG8_LDB(B1, 1, 1); PG8_SCHED; PG8_LDA(At, 1, 0); PG8_STAGE(PG8_SA(0, 1), a2 + hstep, voffA);
            PG8_WAIT_V(8); PG8_WAIT_L(0); PG8_BAR; PG8_MMA(0, 0, At, B0); PG8_MMA(0, 1, At, B1); PG8_BAR; PG8_SCHED;
            if (!hf) PG8_LDA(At, 1, 1); PG8_STAGE(PG8_SB(1, 0), b3, voffB); PG8_STAGE(PG8_SB(1, 1), b3 + hstep, voffB); PG8_STAGE(PG8_SA(1, 0), a3, voffA);
            PG8_WAIT_V(8); PG8_WAIT_L(0); PG8_BAR; if (!hf) { PG8_MMA(1, 0, At, B0); PG8_MMA(1, 1, At, B1); } PG8_BAR; PG8_SCHED;
            } else {
            PG8_LDB(B0, 0, 0); PG8_SCHED; PG8_LDA(At, 0, 0); PG8_STAGE(PG8_SA(1, 1), a1 + hstep, voffA);
            PG8_WAIT_L(8); PG8_BAR; PG8_WAIT_L(0); PG8_MMA(0, 0, At, B0); PG8_BAR; PG8_SCHED;
            PG8_LDB(B1, 0, 1); PG8_STAGE(PG8_SB(0, 0), b2, voffB);
            PG8_BAR; PG8_WAIT_L(0); PG8_MMA(0, 1, At, B1); PG8_BAR;
            PG8_LDA(At, 0, 1); PG8_STAGE(PG8_SA(0, 0), a2, voffA);
            PG8_BAR; PG8_WAIT_L(0); PG8_MMA(1, 0, At, B0); PG8_BAR; PG8_SCHED;
            PG8_STAGE(PG8_SB(0, 1), b2 + hstep, voffB);
            PG8_WAIT_V(6); PG8_BAR; PG8_MMA(1, 1, At, B1); PG8_BAR;
            PG8_LDB(B0, 1, 0); PG8_SCHED; PG8_LDA(At, 1, 0); PG8_STAGE(PG8_SA(0, 1), a2 + hstep, voffA);
            PG8_WAIT_L(8); PG8_BAR; PG8_WAIT_L(0); PG8_MMA(0, 0, At, B0); PG8_BAR; PG8_SCHED;
            PG8_LDB(B1, 1, 1); PG8_STAGE(PG8_SB(1, 0), b3, voffB);
            PG8_BAR; PG8_WAIT_L(0); PG8_MMA(0, 1, At, B1); PG8_BAR;
            PG8_LDA(At, 1, 1); PG8_STAGE(PG8_SA(1, 0), a3, voffA);
            PG8_BAR; PG8_WAIT_L(0); PG8_MMA(1, 0, At, B0); PG8_BAR; PG8_SCHED;
            PG8_STAGE(PG8_SB(1, 1), b3 + hstep, voffB);
            PG8_WAIT_V(6); PG8_BAR; PG8_MMA(1, 1, At, B1); PG8_BAR;
            }
        }
        if constexpr (ALIGN_EPI) { if (wr == 0) PG8_BAR; }
        E(acc, cur, wr, wc, fr, fq);
        if (!has_next) break;
#pragma unroll
        for (int a = 0; a < 2; ++a)
#pragma unroll
            for (int b = 0; b < 2; ++b)
#pragma unroll
                for (int m = 0; m < 4; ++m)
#pragma unroll
                    for (int n = 0; n < 2; ++n) acc[a][b][m][n] = (f32x4){0.f, 0.f, 0.f, 0.f};
        cur = nxt; cA = nA; cB = nB; ++ui;
        if constexpr (ALIGN_EPI) { if (wr == 1) PG8_BAR; }
    }
    PG8_WAIT_V(0);
    if constexpr (!ALIGN_EPI) { if (wr == 0) PG8_BAR; }
    PG8_BAR;
#undef PG8_SA
#undef PG8_SB
#undef PG8_STAGE
#undef PG8_LDA
#undef PG8_LDB
#undef PG8_MMA
#undef PG8_WAIT_V
#undef PG8_WAIT_L
#undef PG8_BAR
#undef PG8_SCHED
}
}
using pg8::Unit;
typedef float f32x2 __attribute__((ext_vector_type(2)));

DI u32x4 pack8(const f32x4 a, const f32x4 b) {
    f32x8 t; t[0] = a[0]; t[1] = a[1]; t[2] = a[2]; t[3] = a[3]; t[4] = b[0]; t[5] = b[1]; t[6] = b[2]; t[7] = b[3];
    return __builtin_bit_cast(u32x4, __builtin_convertvector(t, bf16x8));
}

struct Sched1 {
    int c, G, wbase, nu;
    DI bool next(int i, Unit& u) const {
        const int L = i * G + c; if (L >= nu) return false;
        u.koff = 0; u.nt = 32; u.half = 0;
        if (L < 1344) { const int xcd = L & 7, off = L >> 3; u.pm = 8 * xcd + (off & 7); u.pn = wbase + (off >> 3); }
        else { const int Lp = L - 1344, xcd = Lp & 7, off = Lp >> 3; u.pn = 8 * xcd + (off & 7); u.pm = wbase + 21 + (off >> 3); }
        return true; }
};
struct Sched1H {
    int c, G, wbase;
    DI bool next(int i, Unit& u) const {
        const int h = i * G + c; if (h >= 256) return false;
        const int xcd = h & 7, q = h >> 3, off = 24 + (q >> 1);
        u.koff = 0; u.nt = 32; u.pn = 8 * xcd + (off & 7); u.pm = wbase + 21 + (off >> 3); u.half = 1 + (q & 1);
        return true; }
};
struct Sched2 {
    int c, G, wbase;
    DI bool next(int i, Unit& u) const {
        const int L = i * G + c; if (L >= 448) return false;
        u.half = 0;
        if (L < 320) { const int xcd = L & 7, off = L >> 3; u.pm = 8 * xcd + (off & 7); u.pn = wbase + (off >> 3); const bool isq = (off >> 3) < 3; u.koff = isq ? 0 : 384 * 2; u.nt = isq ? 6 : 2; }
        else { const int Lp = L - 320, xcd = Lp & 7, off = Lp >> 3; u.pn = 8 * xcd + (off & 7); u.pm = wbase + 5 + (off >> 3); u.koff = 384 * 2; u.nt = 2; }
        return true; }
};
struct Sched3 {
    int c, G, wbase;
    DI bool next(int i, Unit& u) const {
        const int L = i * G + c; if (L >= 512) return false;
        const int xcd = L & 7, off = L >> 3; u.pm = 8 * xcd + (off & 7); u.pn = wbase + (off >> 3); u.koff = 0; u.nt = 32; u.half = 0;
        return true; }
};

struct Epi1 {
    static constexpr bool PERM = true;
    bf16* h; bf16* lat; bf16* vT; int wbase; float* ssq;
    const float* rs;
    DI void operator()(const f32x4 (&acc)[2][2][4][2], const Unit& u, int wr, int wc, int fr, int fq) const {
        if (u.pm < 64) {
            const int wt = u.pn - wbase;
            bf16* O; int ldc, colt;
            if (wt < 19) { O = h; ldc = LDH; colt = wt * 256; } else { O = lat; ldc = 512; colt = (wt - 19) * 256; }
            const int row0 = u.pm * 256 + wr * 64 + fr, col0 = colt + wc * 32 + 8 * fq;
            float sc[2][4];
#pragma unroll
            for (int ai = 0; ai < 2; ++ai)
#pragma unroll
                for (int m = 0; m < 4; ++m) sc[ai][m] = frsq(rs[row0 + ai * 128 + m * 16] * (1.f / DM) + EPS);
#pragma unroll
            for (int ai = 0; ai < 2; ++ai)
#pragma unroll
                for (int m = 0; m < 4; ++m) { bf16* rowp = O + (size_t)(row0 + ai * 128 + m * 16) * ldc + col0;
#pragma unroll
                    for (int bj = 0; bj < 2; ++bj) *(u32x4*)(rowp + bj * 128) = pack8(acc[ai][bj][m][0] * sc[ai][m], acc[ai][bj][m][1] * sc[ai][m]); }
            if (wt >= 19) {
#pragma unroll
                for (int ai = 0; ai < 2; ++ai)
#pragma unroll
                    for (int m = 0; m < 4; ++m) { float s2[2];
#pragma unroll
                        for (int bj = 0; bj < 2; ++bj) { const f32x4 a = acc[ai][bj][m][0] * sc[ai][m], b = acc[ai][bj][m][1] * sc[ai][m];
                            float t = a[0] * a[0] + a[1] * a[1] + a[2] * a[2] + a[3] * a[3] + b[0] * b[0] + b[1] * b[1] + b[2] * b[2] + b[3] * b[3];
                            t = xrow_sum(t); t = xhalf_sum(t); s2[bj] = t; }
                        if (fq == 0) { float* sq = ssq + (size_t)(row0 + ai * 128 + m * 16) * 2;
                            if (wt == 19) __hip_atomic_fetch_add(sq, s2[0] + s2[1], __ATOMIC_RELAXED, __HIP_MEMORY_SCOPE_AGENT);
                            else { __hip_atomic_fetch_add(sq, s2[0], __ATOMIC_RELAXED, __HIP_MEMORY_SCOPE_AGENT); __hip_atomic_fetch_add(sq + 1, s2[1], __ATOMIC_RELAXED, __HIP_MEMORY_SCOPE_AGENT); } } }
            }
        } else {
            const int ft = u.pm - wbase - 21;
            const int na = u.half ? 1 : 2;
            const int f0 = ft * 256 + (u.half == 2 ? 128 : 0) + wr * 64 + fr, tok0 = u.pn * 256 + wc * 32 + 8 * fq;
            f32x4 scc[2][2];
#pragma unroll
            for (int bj = 0; bj < 2; ++bj)
#pragma unroll
                for (int n = 0; n < 2; ++n)
#pragma unroll
                    for (int e = 0; e < 4; ++e) scc[bj][n][e] = frsq(rs[tok0 + bj * 128 + n * 4 + e] * (1.f / DM) + EPS);
            if (ft < 2) {
#pragma unroll
                for (int ai = 0; ai < 2; ++ai) if (ai < na)
#pragma unroll
                    for (int m = 0; m < 4; ++m) { bf16* rowp = vT + (size_t)(f0 + ai * 128 + m * 16) * T + tok0;
#pragma unroll
                        for (int bj = 0; bj < 2; ++bj) { f32x4 v0 = acc[ai][bj][m][0] * scc[bj][0], v1 = acc[ai][bj][m][1] * scc[bj][1];
#pragma unroll
                            for (int e = 0; e < 4; ++e) { v0[e] = gelu_t(v0[e]); v1[e] = gelu_t(v1[e]); }
                            *(u32x4*)(rowp + bj * 128) = pack8(v0, v1); } }
            } else {
#pragma unroll
                for (int ai = 0; ai < 2; ++ai) if (ai < na)
#pragma unroll
                    for (int m = 0; m < 4; ++m) { bf16* rowp = vT + (size_t)(f0 + ai * 128 + m * 16) * T + tok0;
#pragma unroll
                        for (int bj = 0; bj < 2; ++bj) *(u32x4*)(rowp + bj * 128) = pack8(acc[ai][bj][m][0] * scc[bj][0], acc[ai][bj][m][1] * scc[bj][1]); }
            }
        }
    }
};
struct Epi2 {
    static constexpr bool PERM = true;
    bf16* qc; bf16* kC; bf16* vCT; const float* stats; int wbase; float* statk; float* statq; const float* gq; const float* gk;
    DI void operator()(const f32x4 (&acc)[2][2][4][2], const Unit& u, int wr, int wc, int fr, int fq) const {
        if (u.pm < 64) {
            const int wt = u.pn - wbase;
            const int row0 = u.pm * 256 + wr * 64 + fr;
            f32x4 gg[2][2];
            if (wt < 3) {
#pragma unroll
                for (int bj = 0; bj < 2; ++bj) { const int c0 = wt * 256 + bj * 128 + wc * 32 + 8 * fq, d0 = c0 % 192;
#pragma unroll
                    for (int n = 0; n < 2; ++n)
#pragma unroll
                        for (int e = 0; e < 4; ++e) gg[bj][n][e] = gq[d0 + n * 4 + e] * (d0 < 128 ? gk[d0 + n * 4 + e] : 1.f); } }
            float scv[2][4];
#pragma unroll
            for (int ai = 0; ai < 2; ++ai)
#pragma unroll
                for (int m = 0; m < 4; ++m) scv[ai][m] = stats[(row0 + ai * 128 + m * 16) * 2 + (wt < 3 ? 0 : 1)];
#pragma unroll
            for (int ai = 0; ai < 2; ++ai)
#pragma unroll
                for (int m = 0; m < 4; ++m) { const int row = row0 + ai * 128 + m * 16; const float sc = frsq(scv[ai][m] * (wt < 3 ? 1.f / 384.f : 1.f / 128.f) + EPS);
#pragma unroll
                    for (int bj = 0; bj < 2; ++bj) {
                        bf16* dst = (wt < 3) ? qc + (size_t)row * 768 + wt * 256 + bj * 128 + wc * 32 + 8 * fq
                                             : kC + (size_t)row * 768 + ((wt - 3) * 2 + bj) * 192 + wc * 32 + 8 * fq;
                        if (wt < 3) {
                            const f32x4 a = acc[ai][bj][m][0] * sc, b = acc[ai][bj][m][1] * sc;
                            *(u32x4*)dst = pack8(a * gg[bj][0], b * gg[bj][1]);
                            float t = a[0] * a[0] + a[1] * a[1] + a[2] * a[2] + a[3] * a[3] + b[0] * b[0] + b[1] * b[1] + b[2] * b[2] + b[3] * b[3];
                            t = xrow_sum(t); t = xhalf_sum(t);
                            if (fq == 0) __hip_atomic_fetch_add(statq + (size_t)row * 4 + (wt * 256 + bj * 128 + wc * 32) / 192, t, __ATOMIC_RELAXED, __HIP_MEMORY_SCOPE_AGENT);
                        } else
                        *(u32x4*)dst = pack8(acc[ai][bj][m][0] * sc, acc[ai][bj][m][1] * sc); }
                    if (wt >= 3) {
#pragma unroll
                        for (int bj = 0; bj < 2; ++bj) { const f32x4 a = acc[ai][bj][m][0] * sc, b = acc[ai][bj][m][1] * sc;
                            float t = a[0] * a[0] + a[1] * a[1] + a[2] * a[2] + a[3] * a[3] + b[0] * b[0] + b[1] * b[1] + b[2] * b[2] + b[3] * b[3];
                            t = xrow_sum(t); t = xhalf_sum(t);
                            if (fq == 0) __hip_atomic_fetch_add(statk + (size_t)row * 4 + (wt - 3) * 2 + bj, t, __ATOMIC_RELAXED, __HIP_MEMORY_SCOPE_AGENT); } } }
        } else {
            const int ft = u.pm - wbase - 5;
            const int f0 = ft * 256 + wr * 64 + fr, tok0 = u.pn * 256 + wc * 32 + 8 * fq;
            f32x4 sc[2][2];
#pragma unroll
            for (int bj = 0; bj < 2; ++bj)
#pragma unroll
                for (int n = 0; n < 2; ++n)
#pragma unroll
                    for (int e = 0; e < 4; ++e) sc[bj][n][e] = frsq(stats[(tok0 + bj * 128 + n * 4 + e) * 2 + 1] * (1.f / 128.f) + EPS);
#pragma unroll
            for (int ai = 0; ai < 2; ++ai)
#pragma unroll
                for (int m = 0; m < 4; ++m) { bf16* rowp = vCT + (size_t)(f0 + ai * 128 + m * 16) * T + tok0;
#pragma unroll
                    for (int bj = 0; bj < 2; ++bj) *(u32x4*)(rowp + bj * 128) = pack8(acc[ai][bj][m][0] * sc[bj][0], acc[ai][bj][m][1] * sc[bj][1]); }
        }
    }
};
template <bool L0>
struct Epi3 {
    static constexpr bool PERM = false;
    const float* xin; const bf16* xb; float* out; bf16* x1b; float* ssq1; int wbase;
    DI void operator()(const f32x4 (&acc)[2][2][4][2], const Unit& u, int wr, int wc, int fr, int fq) const {
        const int row0 = u.pm * 256 + wr * 64 + fr, col0 = (u.pn - wbase) * 256 + wc * 32 + 4 * fq;
#pragma unroll
        for (int ai = 0; ai < 2; ++ai)
#pragma unroll
            for (int mh = 0; mh < 2; ++mh) {
                if constexpr (L0) {
                    bf16x4 xv[2][2][2];
#pragma unroll
                    for (int m2 = 0; m2 < 2; ++m2) { const size_t ro = (size_t)(row0 + ai * 128 + (mh * 2 + m2) * 16) * DM + col0;
#pragma unroll
                        for (int bj = 0; bj < 2; ++bj)
#pragma unroll
                            for (int n = 0; n < 2; ++n) xv[m2][bj][n] = *(const bf16x4*)(x1b + ro + bj * 128 + n * 16); }
#pragma unroll
                    for (int m2 = 0; m2 < 2; ++m2) { const int row = row0 + ai * 128 + (mh * 2 + m2) * 16; const size_t ro = (size_t)row * DM + col0; float t = 0.f;
#pragma unroll
                        for (int bj = 0; bj < 2; ++bj)
#pragma unroll
                            for (int n = 0; n < 2; ++n) { const f32x4 v = __builtin_convertvector(xv[m2][bj][n], f32x4) + acc[ai][bj][mh * 2 + m2][n];
                                t += v[0] * v[0] + v[1] * v[1] + v[2] * v[2] + v[3] * v[3];
                                *(bf16x4*)(x1b + ro + bj * 128 + n * 16) = __builtin_convertvector(v, bf16x4); }
                        t = xrow_sum(t); t = xhalf_sum(t);
                        if (fq == 0) __hip_atomic_fetch_add(ssq1 + row, t, __ATOMIC_RELAXED, __HIP_MEMORY_SCOPE_AGENT); }
                } else {
                    bf16x4 xv[2][2][2];
#pragma unroll
                    for (int m2 = 0; m2 < 2; ++m2) { const size_t ro = (size_t)(row0 + ai * 128 + (mh * 2 + m2) * 16) * DM + col0;
#pragma unroll
                        for (int bj = 0; bj < 2; ++bj)
#pragma unroll
                            for (int n = 0; n < 2; ++n) xv[m2][bj][n] = *(const bf16x4*)(xb + ro + bj * 128 + n * 16); }
#pragma unroll
                    for (int m2 = 0; m2 < 2; ++m2) { const size_t ro = (size_t)(row0 + ai * 128 + (mh * 2 + m2) * 16) * DM + col0;
#pragma unroll
                        for (int bj = 0; bj < 2; ++bj)
#pragma unroll
                            for (int n = 0; n < 2; ++n) *(f32x4*)(out + ro + bj * 128 + n * 16) = __builtin_convertvector(xv[m2][bj][n], f32x4) + acc[ai][bj][mh * 2 + m2][n]; }
                }
            }
    }
};

struct TSub { const float* src; bf16* dst; int valid; };
DI void transpose_tile4(LAS float* lt, const TSub (&sub)[4], int src_ld, const float* gain, int dst_ld, int tid) {
    const int kk = tid >> 4, n4 = (tid & 15) * 4;
    f32x4 v[4][2];
#pragma unroll
    for (int q = 0; q < 4; ++q)
#pragma unroll
        for (int pass = 0; pass < 2; ++pass) {
            v[q][pass] = (f32x4){0.f, 0.f, 0.f, 0.f};
            if (sub[q].src && n4 < sub[q].valid) v[q][pass] = __builtin_nontemporal_load((const f32x4*)(sub[q].src + (size_t)(kk + 32 * pass) * src_ld + n4));
        }
    const float g0 = gain ? gain[kk] : 1.f, g1 = gain ? gain[kk + 32] : 1.f;
    const int n = tid >> 3, k8 = (tid & 7) * 8;
#pragma unroll
    for (int q = 0; q < 4; ++q) {
#pragma unroll
        for (int e = 0; e < 4; ++e) { lt[kk * 65 + n4 + e] = v[q][0][e] * g0; lt[(kk + 32) * 65 + n4 + e] = v[q][1][e] * g1; }
        __syncthreads();
        float o[8];
#pragma unroll
        for (int j = 0; j < 8; ++j) o[j] = lt[(k8 + j) * 65 + n];
        *(bf16x8*)(sub[q].dst + (size_t)n * dst_ld + k8) = cvt8(o);
        __syncthreads();
    }
}
DI int wi_orig(int n0, int& valid) {
    valid = 64;
    if (n0 < 512) return n0;
    if (n0 < 1024) return 1024 + (n0 - 512);
    if (n0 < 1536) return 1536 + (n0 - 1024);
    if (n0 < 2048) return 2176 + (n0 - 1536);
    if (n0 < 2560) return 2760 + (n0 - 2048);
    if (n0 < 3072) return 3848 + (n0 - 2560);
    if (n0 < 3584) return 4360 + (n0 - 3072);
    if (n0 < 4096) return 4872 + (n0 - 3584);
    if (n0 < 4608) return 5896 + (n0 - 4096);
    if (n0 == 4608) return 2048;
    if (n0 == 4672) return 2688;
    if (n0 == 4736) return 3784;
    if (n0 == 4800) { valid = 8; return 2752; }
    if (n0 < 5248) return 3272 + (n0 - 4864);
    if (n0 < 5376) return 3656 + (n0 - 5248);
    if (n0 < 5888) return 512 + (n0 - 5376);
    if (n0 < 6400) return 5384 + (n0 - 5888);
    if (n0 == 6400) return 2112;
    return -1;
}
DI int t5_bucket(int rel) {
    const int n = rel < 0 ? -rel : rel; const int ret = rel > 0 ? 16 : 0;
    int v; if (n < 8) v = n; else { v = 33 - __clz(n * n); if (v > 15) v = 15; }
    return ret + v;
}
DI void prep_x_rows(const float* xin, bf16* xb, unsigned char* ws, int gw, int nw, int lane) {
    float* statx = (float*)(ws + OFF_STATX); float* statl = (float*)(ws + OFF_STATL); float* statk = (float*)(ws + OFF_STATK); float* statq = (float*)(ws + OFF_STATQ);
    for (int row = gw; row < T; row += nw) {
        f32x4 v[8]; float ss = 0.f;
#pragma unroll
        for (int i = 0; i < 8; ++i) { v[i] = *(const f32x4*)(xin + (size_t)row * DM + i * 256 + lane * 4); ss += v[i][0] * v[i][0] + v[i][1] * v[i][1] + v[i][2] * v[i][2] + v[i][3] * v[i][3]; }
        ss = sum8(ss); ss += dppf<DPP_XOR8>(ss); ss = xrow_sum(ss); ss = xhalf_sum(ss);
#pragma unroll
        for (int i = 0; i < 8; ++i) *(bf16x4*)(xb + (size_t)row * DM + i * 256 + lane * 4) = __builtin_convertvector(v[i], bf16x4);
        if (lane == 0) { statx[row] = ss; statx[T + row] = 0.f; }
        if (lane < 4) { statl[(size_t)row * 4 + lane] = 0.f; statk[(size_t)row * 4 + lane] = 0.f; statk[(size_t)T * 4 + (size_t)row * 4 + lane] = 0.f;
            statq[(size_t)row * 4 + lane] = 0.f; statq[(size_t)T * 4 + (size_t)row * 4 + lane] = 0.f; }
    }
}
DI void prep_weights(const Params& p, int l, LAS float* lt, int j0, int step, int tid) {
    bf16* U1 = (bf16*)(p.ws + OFF_U1); bf16* U2 = (bf16*)(p.ws + OFF_U2); bf16* U3 = (bf16*)(p.ws + OFF_U3);
    for (int j = j0; j < 1144; j += step) {
        TSub sub[4];
        if (j < 832) {
            const int ntg = j >> 5, kt = j & 31;
#pragma unroll
            for (int q = 0; q < 4; ++q) { const int nt = ntg * 4 + q; int valid; const int oc = wi_orig(nt * 64, valid);
                sub[q].src = oc < 0 ? nullptr : p.w_in + (size_t)l * DM * INC + (size_t)(kt * 64) * INC + oc; sub[q].valid = valid;
                sub[q].dst = U1 + (size_t)(64 + 26 * l) * 256 * 2048 + (size_t)(nt * 64) * 2048 + kt * 64; }
            transpose_tile4(lt, sub, INC, p.norm_g + l * DM + kt * 64, 2048, tid);
        } else if (j < 1088) {
            const int jj = j - 832, ntg = jj >> 5, kt = jj & 31;
#pragma unroll
            for (int q = 0; q < 4; ++q) { const int nt = ntg * 4 + q;
                sub[q].src = p.w_out + (size_t)l * DM * DM + (size_t)(kt * 64) * DM + nt * 64; sub[q].valid = 64;
                sub[q].dst = U3 + (size_t)(64 + 8 * l) * 256 * 2048 + (size_t)(nt * 64) * 2048 + kt * 64; }
            transpose_tile4(lt, sub, DM, nullptr, 2048, tid);
        } else {
            const int jj = j - 1088, ntg = jj >> 3, kt = jj & 7;
            const bool isq = ntg < 3; const bool live = isq ? (kt < 6) : (kt >= 6);
#pragma unroll
            for (int q = 0; q < 4; ++q) { const int nt = ntg * 4 + q; const float* src = nullptr;
                if (live) { if (isq) src = p.c_w_qb + (size_t)l * 384 * 768 + (size_t)(kt * 64) * 768 + nt * 64;
                    else { const int np = (nt - 12) * 64; const int oc = np < 512 ? (np >> 7) * 256 + (np & 127) : ((np - 512) >> 7) * 256 + 128 + ((np - 512) & 127);
                        src = p.c_w_kvb + (size_t)l * 128 * 1024 + (size_t)((kt - 6) * 64) * 1024 + oc; } }
                sub[q].src = src; sub[q].valid = 64; sub[q].dst = U2 + (size_t)(64 + 7 * l) * 256 * 512 + (size_t)(nt * 64) * 512 + kt * 64; }
            const float* gain = !live ? nullptr : (isq ? p.c_qa_gain + l * 384 + kt * 64 : p.c_kva_gain + l * 128 + (kt - 6) * 64);
            transpose_tile4(lt, sub, isq ? 768 : 1024, gain, 512, tid);
        }
    }
}
DI void phase_prep(const Params& p, LAS unsigned char* lds, int G, int wv) {
    const int tid = opaque_tid(wv), blk = blockIdx.x;
    prep_weights(p, 0, (LAS float*)lds, blk, G, tid);
    bf16* U1 = (bf16*)(p.ws + OFF_U1);
    const int gt = blk * 512 + tid, nthr = G * 512;
    bf16* Wa = (bf16*)(p.ws + OFF_WA);
    for (int e = gt; e < 2 * 4 * 128 * 128; e += nthr) { const int jx = e & 127, ix = (e >> 7) & 127; Wa[e] = (bf16)(((jx >> 6) <= (ix >> 6)) ? p.a_ws[e] : 0.f); }
    float* ct = (float*)(p.ws + OFF_COS); float* st = (float*)(p.ws + OFF_SIN);
    for (int e = gt; e < 2048 * 32; e += nthr) { const int pos = e >> 5, i = e & 31; const float inv = exp2f(-(float)(2 * i) * (13.287712379549449f / 64.f)); const float ang = (float)pos * inv;
        ct[e] = cosf(ang); st[e] = sinf(ang); }
    float* t5 = (float*)(p.ws + OFF_T5);
    for (int e = gt; e < 8 * 2112; e += nthr) { const int hd = e / 2112, idx = e % 2112; t5[e] = p.t5_bias[t5_bucket(idx - 2047) * 8 + hd] * LOG2E; }
    float* dt = (float*)(p.ws + OFF_DT);
    for (int e = gt; e < 2 * 8 * 264; e += nthr) { const int l = e / (8 * 264), hd = (e / 264) & 7, i = e % 264; dt[e] = (i < 257) ? p.d_rel_bias[(size_t)l * 257 * 8 + i * 8 + hd] * LOG2E : 0.f; }
    prep_x_rows(p.x, U1, p.ws, (tid >> 6) * G + blk, 8 * G, tid & 63);
}

DI unsigned fkey(float f) { unsigned b = __float_as_uint(f); if (b == 0x80000000u) b = 0u; return (b & 0x80000000u) ? ~b : (b | 0x80000000u); }
DI unsigned wave_sum_u32(unsigned x) {
    x += (unsigned)__builtin_amdgcn_update_dpp(0, (int)x, 0xB1, 0xF, 0xF, true);
    x += (unsigned)__builtin_amdgcn_update_dpp(0, (int)x, 0x4E, 0xF, 0xF, true);
    x += (unsigned)__builtin_amdgcn_update_dpp(0, (int)x, 0x141, 0xF, 0xF, true);
    x += (unsigned)__builtin_amdgcn_update_dpp(0, (int)x, 0x140, 0xF, 0xF, true);
    return (unsigned)__builtin_amdgcn_readlane((int)x, 0) + (unsigned)__builtin_amdgcn_readlane((int)x, 16) + (unsigned)__builtin_amdgcn_readlane((int)x, 32) + (unsigned)__builtin_amdgcn_readlane((int)x, 48);
}
template <int NMX>
DI unsigned long long sel_ties(const unsigned (&u)[NMX], unsigned prefix, int lane) {
    unsigned long long myw = 0ull; int cgt = 0;
#pragma unroll
    for (int m = 0; m < NMX; ++m) cgt += __popcll(__ballot(u[m] > prefix));
    int need = 256 - cgt;
#pragma unroll
    for (int m = 0; m < NMX; ++m) {
        const unsigned long long gtm = __ballot(u[m] > prefix), eqm = __ballot(u[m] == prefix);
        const int ne = __popcll(eqm); const int take = need < ne ? need : ne; need -= take;
        const unsigned long long below = (lane == 0) ? 0ull : (~0ull >> (64 - lane));
        const bool sel = (u[m] == prefix) && (__popcll(eqm & below) < take);
        const unsigned long long bm = gtm | __ballot(sel);
        myw = (lane == m) ? bm : myw; }
    return myw;
}
template <int NMX>
DI void sel_rows2(const LAS float* row0, const LAS float* row1, int nm, int lane, unsigned long long& w0, unsigned long long& w1) {
    unsigned u0[NMX], u1[NMX];
#pragma unroll
    for (int m = 0; m < NMX; ++m) { u0[m] = (m < nm) ? fkey(row0[m * 64 + lane]) : 0u; u1[m] = (m < nm) ? fkey(row1[m * 64 + lane]) : 0u; }
    unsigned p0 = 0u, p1 = 0u; bool e0 = false, e1 = false;
    for (int bit = 31; bit >= 0; --bit) {
        const unsigned c0 = p0 | (1u << bit), c1 = p1 | (1u << bit);
        unsigned n0 = 0u, n1 = 0u;
#define CNT4(n, c, a0_, a1_, a2_, a3_) asm("v_cmp_le_u32_e64 s[20:21], %1, %2\n\tv_cmp_le_u32_e64 s[22:23], %1, %3\n\tv_cmp_le_u32_e64 s[24:25], %1, %4\n\tv_cmp_le_u32_e64 s[26:27], %1, %5\n\t" \
            "v_addc_co_u32_e64 %0, vcc, 0, %0, s[20:21]\n\tv_addc_co_u32_e64 %0, vcc, 0, %0, s[22:23]\n\tv_addc_co_u32_e64 %0, vcc, 0, %0, s[24:25]\n\tv_addc_co_u32_e64 %0, vcc, 0, %0, s[26:27]" \
            : "+v"(n) : "s"(c), "v"(a0_), "v"(a1_), "v"(a2_), "v"(a3_) : "s20", "s21", "s22", "s23", "s24", "s25", "s26", "s27", "vcc")
        const unsigned cs0 = (unsigned)__builtin_amdgcn_readfirstlane((int)c0), cs1 = (unsigned)__builtin_amdgcn_readfirstlane((int)c1);
#pragma unroll
        for (int m = 0; m < NMX; m += 4) { CNT4(n0, cs0, u0[m], u0[m + 1], u0[m + 2], u0[m + 3]); CNT4(n1, cs1, u1[m], u1[m + 1], u1[m + 2], u1[m + 3]); }
#undef CNT4
        const unsigned tot = wave_sum_u32(n0 | (n1 << 16));
        const unsigned t0 = tot & 0xffffu, t1 = tot >> 16;
        if (!e0) { if (t0 >= 256u) p0 = c0; if (t0 == 256u) e0 = true; }
        if (!e1) { if (t1 >= 256u) p1 = c1; if (t1 == 256u) e1 = true; }
        if (e0 && e1) break;
    }
    if (e0) { w0 = 0ull;
#pragma unroll
        for (int m = 0; m < NMX; ++m) { const unsigned long long bm = __ballot(u0[m] >= p0); w0 = (lane == m) ? bm : w0; }
    } else w0 = sel_ties<NMX>(u0, p0, lane);
    if (e1) { w1 = 0ull;
#pragma unroll
        for (int m = 0; m < NMX; ++m) { const unsigned long long bm = __ballot(u1[m] >= p1); w1 = (lane == m) ? bm : w1; }
    } else w1 = sel_ties<NMX>(u1, p1, lane);
}
struct SelRegs { bf16x8 qf[8][2]; bf16x8 wv; bf16x8 a0[4], a1[4]; };
#define SEL_LOADK(A0, A1, trip) do { _Pragma("unroll") for (int u = 0; u < 4; ++u) { const int kt = w + 32 * (trip) + 8 * u; const int ktc = kt < ntile ? kt : w; \
        const bf16* krow = h + (size_t)(b * S + ktc * 16 + fr) * LDH + H_BIK + fq * 8; A0[u] = *(const bf16x8*)krow; A1[u] = *(const bf16x8*)(krow + 32); } } while (0)
DI void sel_load(SelRegs& R, const bf16* h, int b, int qg, int w, int fr, int fq) {
    const int s0 = qg * 16, t0 = b * S + s0, ntile = ((s0 >> 6) + 1) * 4;
    const bf16* qrow = h + (size_t)(t0 + fr) * LDH;
#pragma unroll
    for (int hd = 0; hd < 8; ++hd)
#pragma unroll
        for (int ks = 0; ks < 2; ++ks) R.qf[hd][ks] = *(const bf16x8*)(qrow + H_BIQ + hd * 64 + ks * 32 + fq * 8);
    R.wv = *(const bf16x8*)(qrow + H_BIW);
    SEL_LOADK(R.a0, R.a1, 0);
}
DI void sel_scores(SelRegs& R, const bf16* h, int b, int qg, LAS float* sc, int w, int fr, int fq) {
    const int s0 = qg * 16, ntile = ((s0 >> 6) + 1) * 4, ntrip = (ntile + 31) >> 5;
    float wgt[8];
#pragma unroll
    for (int hd = 0; hd < 8; ++hd) wgt[hd] = (float)R.wv[hd] * C_IW;
#define SEL_COMPUTE(A0, A1, trip) do { _Pragma("unroll") for (int u = 0; u < 4; ++u) { const int kt = w + 32 * (trip) + 8 * u; \
        if (kt < ntile) { float s4[4] = {0.f, 0.f, 0.f, 0.f}; \
            _Pragma("unroll") for (int hd = 0; hd < 8; ++hd) { f32x4 a = {0.f, 0.f, 0.f, 0.f}; a = MFMA16(A0[u], R.qf[hd][0], a); a = MFMA16(A1[u], R.qf[hd][1], a); \
                _Pragma("unroll") for (int r = 0; r < 4; ++r) { const float rl = relu_i(a[r]); asm("v_fma_f32 %0, %1, %2, %0" : "+v"(s4[r]) : "v"(wgt[hd]), "v"(rl)); } } \
            *(LAS f32x4*)(sc + fr * SCLD + kt * 16 + fq * 4) = (f32x4){s4[0], s4[1], s4[2], s4[3]}; } } } while (0)
    bf16x8 b0[4], b1[4];
    for (int tp = 0; tp < ntrip; tp += 2) {
        SEL_LOADK(b0, b1, tp + 1);
        SEL_COMPUTE(R.a0, R.a1, tp);
        if (tp + 1 >= ntrip) break;
        SEL_LOADK(R.a0, R.a1, tp + 2);
        SEL_COMPUTE(b0, b1, tp + 1);
    }
#undef SEL_COMPUTE
}
#undef SEL_LOADK
DI void sel_select(unsigned* mask, int b, int qg, LAS float* sc, int w, int lane) {
    const int s0 = qg * 16, t0 = b * S + s0, nm = (s0 >> 6) + 1;
    const int q = 2 * w;
    unsigned long long w0 = ~0ull, w1 = ~0ull;
    if (nm <= 4) { }
    else if (nm <= 8) sel_rows2<8>(sc + q * SCLD, sc + (q + 1) * SCLD, nm, lane, w0, w1);
    else if (nm <= 16) sel_rows2<16>(sc + q * SCLD, sc + (q + 1) * SCLD, nm, lane, w0, w1);
    else if (nm <= 24) sel_rows2<24>(sc + q * SCLD, sc + (q + 1) * SCLD, nm, lane, w0, w1);
    else sel_rows2<32>(sc + q * SCLD, sc + (q + 1) * SCLD, nm, lane, w0, w1);
    if (lane < nm) { *(unsigned long long*)(mask + (size_t)(t0 + q) * 64 + 2 * lane) = w0; *(unsigned long long*)(mask + (size_t)(t0 + q + 1) * 64 + 2 * lane) = w1; }
}

DI void norm8(float (&x)[8], const float (&gain)[8], float scale) {
    float ss = 0.f;
#pragma unroll
    for (int j = 0; j < 8; ++j) ss += x[j] * x[j];
    ss = sum8(ss);
    const float rstd = frsq(ss * (1.f / 64.f) + EPS) * scale;
#pragma unroll
    for (int j = 0; j < 8; ++j) x[j] = x[j] * rstd * gain[j];
}
struct P1Gains { float bq[8], dq[8], dk[8], bk[8], kr[8]; float* sk; };
template <int NR>
DI void post1_rows(const Params& p, const P1Gains& g, const int (&t)[NR], int lane) {
    bf16x8 vdk[NR], vk[NR], vkr[NR]; f32x4 kcs[NR][2], ksn[NR][2];
#pragma unroll
    for (int i = 0; i < NR; ++i) {
        const bf16* hrow = (const bf16*)(p.ws + OFF_H) + (size_t)t[i] * LDH;
        vdk[i] = *(const bf16x8*)(hrow + H_DK + lane * 8);
        vk[i] = *(const bf16x8*)(hrow + H_BK + (lane & 7) * 8);
        vkr[i] = *(const bf16x8*)(hrow + H_CKR + (lane & 7) * 8);
        { const float* ct = (const float*)(p.ws + OFF_COS) + (size_t)(t[i] & (S - 1)) * 32 + (lane & 3) * 8; const float* sn = (const float*)(p.ws + OFF_SIN) + (size_t)(t[i] & (S - 1)) * 32 + (lane & 3) * 8;
          kcs[i][0] = *(const f32x4*)ct; kcs[i][1] = *(const f32x4*)(ct + 4); ksn[i][0] = *(const f32x4*)sn; ksn[i][1] = *(const f32x4*)(sn + 4); }
    }
#pragma unroll
    for (int i = 0; i < NR; ++i) {
        bf16* hrow = (bf16*)(p.ws + OFF_H) + (size_t)t[i] * LDH;
        float x[8];
#pragma unroll
        for (int j = 0; j < 8; ++j) x[j] = (float)vdk[i][j];
        norm8(x, g.dk, 1.f); *(bf16x8*)(hrow + H_DK + lane * 8) = cvt8(x);
#pragma unroll
        for (int j = 0; j < 8; ++j) x[j] = (float)vk[i][j];
        norm8(x, g.bk, 1.f); if (lane < 8) *(bf16x8*)(hrow + H_BK + lane * 8) = cvt8(x);
        { float ss = 0.f, xg[8], o8[8];
#pragma unroll
          for (int j = 0; j < 8; ++j) { const float xr = (float)vkr[i][j]; ss += xr * xr; xg[j] = xr * g.kr[j]; }
          ss = sum8(ss);
#pragma unroll
          for (int j = 0; j < 8; ++j) { const float ot = dpp_xor4(xg[j]), cs = kcs[i][j >> 2][j & 3], si = ksn[i][j >> 2][j & 3];
              o8[j] = (lane & 4) ? ot * si + xg[j] * cs : xg[j] * cs - ot * si; }
          if (lane < 32) *(bf16x8*)((bf16*)(p.ws + OFF_KC) + (size_t)t[i] * 768 + (lane >> 3) * 192 + 128 + (lane & 7) * 8) = cvt8(o8);
          if (lane < 4) __hip_atomic_fetch_add(g.sk + (size_t)t[i] * 4 + lane, ss, __ATOMIC_RELAXED, __HIP_MEMORY_SCOPE_AGENT); }
    }
}

struct AttnWave { const bf16* Q; int ldq; const bf16* Z; bf16* Y; int s0, kbeg, kend; int hd; };
template <int DK, int DV> struct AttnCfg {
    static constexpr int KST = DK * 2 + 16, VST = 144;
    static constexpr int KBYTES = 64 * KST, VBYTES = DV * VST, RKB = (DK == 192) ? 256 : 0, STG = KBYTES + VBYTES + RKB;
    static constexpr int CPR = DK / 8, NKL = (64 * CPR) / 512, NVL = (DV * 8) / 512;
    static constexpr int TAB_OFF = 2 * STG, MSK_OFF = TAB_OFF + 8 * 256 * 4, MSK_LD = 65;
};
template <int DK, int DV, int MODE>
DI void attn_stage(LAS unsigned char* kb, const int k0, const AttnWave& aw, const bf16x8 (&qf)[DK / 16], f32x16 (&o)[DV / 32], float& m_run, float& l0, float& l1, f32x16& bmv,
                   const float bfar, const LAS float* wtab, const LAS unsigned* lmsk, const int r, const int hh, const int pr) {
    typedef AttnCfg<DK, DV> C;
    constexpr int J = (DK == 64) ? 2 : 1;
    LAS unsigned char* vb = kb + C::KBYTES;
    if (!(k0 >= aw.kbeg && k0 < aw.kend)) return;
#pragma unroll
    for (int g0 = 0; g0 < 2; g0 += J) {
        const bool first = (k0 + 32 * g0 == aw.kbeg);
        f32x16 st[J];
        constexpr int NKF = DK / 16 < 8 ? DK / 16 : 8;
        bf16x8 kf[J][NKF];
#pragma unroll
        for (int j = 0; j < J; ++j) {
            if (MODE == 0) {
#pragma unroll
                for (int i = 0; i < 16; ++i) st[j][i] = 0.f;
            }
#pragma unroll
            for (int s = 0; s < NKF; ++s) kf[j][s] = *(const LAS bf16x8*)(kb + (32 * (g0 + j) + pr) * C::KST + 16 * hh + 32 * s);
        }
        f32x4 rk0, rk1, rk2, rk3;
        if (MODE == 0) { const LAS float* rkp = (const LAS float*)(vb + C::VBYTES) + 32 * g0 + 8 * hh;
            rk0 = *(const LAS f32x4*)rkp; rk1 = *(const LAS f32x4*)(rkp + 4); rk2 = *(const LAS f32x4*)(rkp + 16); rk3 = *(const LAS f32x4*)(rkp + 20); }
        __builtin_amdgcn_sched_barrier(0);
#pragma unroll
        for (int s = 0; s < DK / 16; ++s)
#pragma unroll
            for (int j = 0; j < J; ++j) {
                if (MODE != 0 && s == 0) {
                    const int kk0 = k0 + 32 * (g0 + j);
                    if (kk0 + 31 + 128 <= aw.s0) st[j] = MFMA32(kf[j][0], qf[0], bmv);
                    else {
                        const int base = kk0 + 8 * hh - (aw.s0 + r);
                        float ci[16];
#pragma unroll
                        for (int i = 0; i < 16; ++i) { const float wt = wtab[base + 16 * (i >> 3) + (i & 7) + 192];
                            asm("v_sub_f32 %0, %1, %2" : "=v"(ci[i]) : "v"(wt), "v"(m_run)); }
                        f32x16 cv;
#pragma unroll
                        for (int i = 0; i < 16; ++i) cv[i] = ci[i];
                        st[j] = MFMA32(kf[j][0], qf[0], cv);
                    }
                } else st[j] = MFMA32(kf[j][s % NKF], qf[s], st[j]);
                if (s + NKF < DK / 16) kf[j][s % NKF] = *(const LAS bf16x8*)(kb + (32 * (g0 + j) + pr) * C::KST + 16 * hh + 32 * (s + NKF)); }
        bf16x8 vf[J][DV / 32][2];
#pragma unroll
        for (int j = 0; j < J; ++j)
#pragma unroll
            for (int d = 0; d < DV / 32; ++d)
#pragma unroll
                for (int s2 = 0; s2 < 2; ++s2) vf[j][d][s2] = *(const LAS bf16x8*)(vb + (32 * d + r) * C::VST + (32 * (g0 + j) + 16 * s2 + 8 * hh) * 2);
        __builtin_amdgcn_sched_barrier(0);
        if (MODE == 0) {
#pragma unroll
            for (int i = 0; i < 4; ++i) { st[0][i] = __builtin_fmaf(st[0][i], rk0[i], -m_run); st[0][4 + i] = __builtin_fmaf(st[0][4 + i], rk1[i], -m_run);
                st[0][8 + i] = __builtin_fmaf(st[0][8 + i], rk2[i], -m_run); st[0][12 + i] = __builtin_fmaf(st[0][12 + i], rk3[i], -m_run); }
        }
        float mx = fmaxf(fmaxf(st[0][0], st[0][1]), st[0][2]);
#pragma unroll
        for (int i = 3; i < 15; i += 2) mx = fmaxf(fmaxf(mx, st[0][i]), st[0][i + 1]);
        mx = fmaxf(mx, st[0][15]);
        if (J == 2) {
#pragma unroll
            for (int i = 0; i < 16; i += 2) mx = fmaxf(fmaxf(mx, st[J - 1][i]), st[J - 1][i + 1]);
        }
        mx = xhalf_max(mx);
        if (first || !__all(mx <= 8.f)) {
            const float d = first ? mx : fmaxf(mx, 0.f), alpha = fexp2(-d);
            m_run += d; l0 *= alpha; l1 *= alpha;
            if (MODE != 0) { const float bm = bfar - m_run;
#pragma unroll
                for (int i = 0; i < 16; ++i) bmv[i] = bm; }
#pragma unroll
            for (int dd = 0; dd < DV / 32; ++dd)
#pragma unroll
                for (int i = 0; i < 16; ++i) o[dd][i] *= alpha;
#pragma unroll
            for (int j = 0; j < J; ++j)
#pragma unroll
                for (int i = 0; i < 16; ++i) st[j][i] -= d;
        }
#pragma unroll
        for (int j = 0; j < J; ++j) {
            float pv[16];
#pragma unroll
            for (int i = 0; i < 16; ++i) pv[i] = fexp2(st[j][i]);
            if (MODE == 1) {
                __builtin_amdgcn_sched_barrier(0);
                const unsigned mw = lmsk[r * C::MSK_LD + ((k0 + 32 * (g0 + j)) >> 5)] >> (8 * hh);
#define MASK_AND(i) asm("v_bfe_i32 %0, %1, %2, 1\n\tv_and_b32 %0, %0, %3" : "=&v"(pv[i]) : "v"(mw), "n"(16 * ((i) >> 3) + ((i) & 7)), "v"(pv[i]))
                MASK_AND(0); MASK_AND(1); MASK_AND(2); MASK_AND(3); MASK_AND(4); MASK_AND(5); MASK_AND(6); MASK_AND(7);
                MASK_AND(8); MASK_AND(9); MASK_AND(10); MASK_AND(11); MASK_AND(12); MASK_AND(13); MASK_AND(14); MASK_AND(15);
#undef MASK_AND
            }
            if (MODE != 1) {
                __builtin_amdgcn_sched_barrier(0); asm volatile("s_nop 0"); }
#pragma unroll
            for (int i = 0; i < 8; ++i) {
                asm volatile("v_add_f32 %0, %0, %1" : "+v"(l0) : "v"(pv[2 * i])); asm volatile("v_add_f32 %0, %0, %1" : "+v"(l1) : "v"(pv[2 * i + 1])); }
            bf16x8 pf[2];
#pragma unroll
            for (int s2 = 0; s2 < 2; ++s2) { f32x8 t8;
#pragma unroll
                for (int jj = 0; jj < 8; ++jj) t8[jj] = pv[8 * s2 + jj];
                pf[s2] = __builtin_convertvector(t8, bf16x8); }
#pragma unroll
            for (int d = 0; d < DV / 32; ++d)
#pragma unroll
                for (int s2 = 0; s2 < 2; ++s2) o[d] = MFMA32(vf[j][d][s2], pf[s2], o[d]);
        }
    }
}
template <int DK, int DV, int MODE>
DI void attn_block(LAS unsigned char* lds, const bf16* Kg, int ldk, const bf16* VTg, int kb0, int kb1, const AttnWave aw, const float* gtab, const unsigned* gmask, int tid, const Params& p, int l, int b) {
    typedef AttnCfg<DK, DV> C;
    constexpr int NKL = C::NKL, NVL = C::NVL, STG = C::STG;
    static_assert(C::MSK_OFF + 32 * C::MSK_LD * 4 <= LDS_MISC, "attention LDS exceeds budget");
    const int lane = tid & 63, r = lane & 31, hh = lane >> 5;
    const int pr = (r & 0x13) | ((r & 8) >> 1) | ((r & 4) << 1);
    LAS float* ltab = (LAS float*)(lds + C::TAB_OFF); LAS unsigned* lmsk = (LAS unsigned*)(lds + C::MSK_OFF);
    if (MODE == 1) {
#pragma unroll
        for (int e = tid; e < 2048; e += 512) { const int hd = e >> 8, i = e & 255; ltab[e] = gtab[hd * 2112 + i - 192 + 2047]; }
#pragma unroll
        for (int e = tid; e < 2048; e += 512) { const int q = e >> 6, wd = e & 63; lmsk[q * C::MSK_LD + wd] = gmask[(size_t)q * 64 + wd]; }
    } else if (MODE == 2) {
        if (tid < 256) { int d = 192 - tid; d = d < -128 ? -128 : (d > 128 ? 128 : d); ltab[tid] = gtab[d + 128]; }
    }
    bf16x8 qf[DK / 16];
#pragma unroll
    for (int s = 0; s < DK / 16; ++s) qf[s] = *(const bf16x8*)(aw.Q + (size_t)r * aw.ldq + 16 * s + 8 * hh);
    const float* kstat = (const float*)(p.ws + OFF_STATK) + (size_t)l * T * 4 + (size_t)b * S * 4 + aw.hd;
    if constexpr (MODE != 0) {
        const float* gq_ = (MODE == 1 ? p.b_q_gain : p.d_q_gain) + l * 64;
        float ssq = 0.f;
#pragma unroll
        for (int s = 0; s < 4; ++s)
#pragma unroll
            for (int j = 0; j < 8; ++j) { const float x = (float)qf[s][j]; ssq += x * x; }
        ssq = xhalf_sum(ssq);
        const float rq = frsq(ssq * (1.f / 64.f) + EPS) * SCALE_64;
#pragma unroll
        for (int s = 0; s < 4; ++s) { const f32x4 ga = *(const f32x4*)(gq_ + 16 * s + 8 * hh), gb = *(const f32x4*)(gq_ + 16 * s + 8 * hh + 4); float x[8];
#pragma unroll
            for (int j = 0; j < 4; ++j) { x[j] = (float)qf[s][j] * rq * ga[j]; x[4 + j] = (float)qf[s][4 + j] * rq * gb[j]; }
            qf[s] = cvt8(x); }
    }
    if constexpr (MODE == 0) {
        const size_t tq_ = (size_t)b * S + aw.s0 + r;
        const float rq = frsq(((const float*)(p.ws + OFF_STATQ))[(size_t)l * T * 4 + tq_ * 4 + aw.hd] * (1.f / 192.f) + EPS) * SCALE_192;
#pragma unroll
        for (int s = 0; s < 8; ++s) { float x[8];
#pragma unroll
            for (int j = 0; j < 8; ++j) x[j] = (float)qf[s][j] * rq;
            qf[s] = cvt8(x); }
        const float* cs_ = (const float*)(p.ws + OFF_COS) + (size_t)(aw.s0 + r) * 32; const float* sn_ = (const float*)(p.ws + OFF_SIN) + (size_t)(aw.s0 + r) * 32;
#pragma unroll
        for (int s = 8; s < 10; ++s) {
            const int i0 = 16 * (s - 8) + 8 * hh;
            const f32x4 ca = *(const f32x4*)(cs_ + i0), cb = *(const f32x4*)(cs_ + i0 + 4), sa = *(const f32x4*)(sn_ + i0), sb = *(const f32x4*)(sn_ + i0 + 4);
            float xa[8], xb[8];
#pragma unroll
            for (int j = 0; j < 8; ++j) { const float a = (float)qf[s][j] * rq, bq = (float)qf[s + 2][j] * rq;
                const float c = j < 4 ? ca[j & 3] : cb[j & 3], sv = j < 4 ? sa[j & 3] : sb[j & 3];
                xa[j] = a * c - bq * sv; xb[j] = bq * c + a * sv; }
            qf[s] = cvt8(xa); qf[s + 2] = cvt8(xb);
        }
    }
    f32x16 o[DV / 32];
#pragma unroll
    for (int d = 0; d < DV / 32; ++d)
#pragma unroll
        for (int i = 0; i < 16; ++i) o[d][i] = 0.f;
    float m_run = 0.f, l0 = 0.f, l1 = 0.f;
    const float bfar = (MODE == 1) ? gtab[aw.hd * 2112] : (MODE == 2 ? gtab[256] : 0.f);
    const LAS float* wtab = ltab + (MODE == 1 ? aw.hd * 256 : 0);
    f32x16 bmv;
#pragma unroll
    for (int i = 0; i < 16; ++i) bmv[i] = bfar;
    unsigned kgo[NKL], vgo[NVL]; int kl[NKL], vl[NVL];
#pragma unroll
    for (int i = 0; i < NKL; ++i) { const int c = tid + 512 * i, row = c / C::CPR, ch = c % C::CPR; kgo[i] = (unsigned)(row * ldk + ch * 8) * 2u; kl[i] = row * C::KST + ch * 16; }
#pragma unroll
    for (int i = 0; i < NVL; ++i) { const int c = tid + 512 * i, d = c >> 3, ch = c & 7; vgo[i] = (unsigned)(d * T + ch * 8) * 2u; vl[i] = C::KBYTES + d * C::VST + ch * 16; }
    u32x4 krA[NKL], vrA[NVL]; float skA = 0.f;
#define AT_LOAD(KR, VR, kk) do { const char* kbase_ = (const char*)(Kg + (size_t)(kk) * ldk); const char* vbase_ = (const char*)(VTg + (kk)); \
        _Pragma("unroll") for (int i = 0; i < NKL; ++i) KR[i] = *(const u32x4*)(kbase_ + kgo[i]); \
        _Pragma("unroll") for (int i = 0; i < NVL; ++i) VR[i] = *(const u32x4*)(vbase_ + vgo[i]); \
        if (MODE == 0 && tid < 64) skA = kstat[(size_t)((kk) + tid) * 4]; } while (0)
#define AT_WRITE(KR, VR, boff) do { \
        _Pragma("unroll") for (int i = 0; i < NKL; ++i) *(LAS u32x4*)(lds + (boff) + kl[i]) = KR[i]; \
        _Pragma("unroll") for (int i = 0; i < NVL; ++i) *(LAS u32x4*)(lds + (boff) + vl[i]) = VR[i]; \
        if (MODE == 0 && tid < 64) *(LAS float*)(lds + (boff) + C::KBYTES + C::VBYTES + tid * 4) = frsq(skA * (1.f / 192.f) + EPS); } while (0)
    const int klast = kb1 - 64;
    AT_LOAD(krA, vrA, kb0);
    AT_WRITE(krA, vrA, 0);
#pragma unroll
    for (int s = 0; s < DK / 16; ++s) asm volatile("" :: "v"(qf[s]));
    asm volatile("" :: "v"(bfar));
    __syncthreads();
    int cur = 0;
    for (int k0 = kb0; k0 < kb1; k0 += 64) {
        AT_LOAD(krA, vrA, (k0 + 64 < klast ? k0 + 64 : klast));
        attn_stage<DK, DV, MODE>(lds + cur * STG, k0, aw, qf, o, m_run, l0, l1, bmv, bfar, wtab, lmsk, r, hh, pr);
        AT_WRITE(krA, vrA, (cur ^ 1) * STG);
        __syncthreads();
        cur ^= 1;
    }
#undef AT_LOAD
#undef AT_WRITE
    const float lt = xhalf_sum(l0 + l1), inv = frcp(lt);
    bf16x4 zv[DV / 32][4];
#pragma unroll
    for (int d = 0; d < DV / 32; ++d)
#pragma unroll
        for (int g = 0; g < 4; ++g) zv[d][g] = *(const bf16x4*)(aw.Z + (size_t)r * LDH + 32 * d + 8 * g + 4 * hh);
#pragma unroll
    for (int d = 0; d < DV / 32; ++d)
#pragma unroll
        for (int g = 0; g < 4; ++g) {
            const int dd = 32 * d + 8 * g + 4 * hh;
            f32x4 ov;
#pragma unroll
            for (int e = 0; e < 4; ++e) ov[e] = o[d][4 * g + e] * inv * silu_f((float)zv[d][g][e]);
            *(bf16x4*)(aw.Y + (size_t)r * DM + dd) = __builtin_convertvector(ov, bf16x4);
        }
}

DI void avnorm_item(const Params& p, int item, LAS float* ls, int tid) {
    const int tb = item * 128, c = tid & 15, frow = tid >> 4, w = tid >> 6;
    const bf16* src = (const bf16*)(p.ws + OFF_VT) + (size_t)(VT_AV + frow) * T + tb + c * 8;
    float acc[8];
#pragma unroll
    for (int j = 0; j < 8; ++j) acc[j] = 0.f;
#pragma unroll
    for (int i = 0; i < 16; ++i) { const bf16x8 v = *(const bf16x8*)(src + (size_t)(32 * i) * T);
#pragma unroll
        for (int j = 0; j < 8; ++j) { const float f = (float)v[j]; acc[j] += f * f; } }
#pragma unroll
    for (int j = 0; j < 8; ++j) { acc[j] = xrow_sum(acc[j]); acc[j] = xhalf_sum(acc[j]); }
    if ((tid & 63) < 16) {
#pragma unroll
        for (int j = 0; j < 8; ++j) ls[w * 128 + c * 8 + j] = acc[j];
    }
    __syncthreads();
    if (tid < 128) { float sum = 0.f;
#pragma unroll
        for (int k = 0; k < 8; ++k) sum += ls[k * 128 + tid];
        ((float*)(p.ws + OFF_SSV))[tb + tid] = frsq(sum * (1.f / 512.f) + EPS); }
    __syncthreads();
}
DI void mixA_item(const Params& p, int l, int item, int tid) {
    const int w = __builtin_amdgcn_readfirstlane(tid >> 6), lane = tid & 63, r = lane & 31, hh = lane >> 5;
    const int g = item & 3, n = (item >> 2) & 15, b = item >> 6, tb = b * S + n * 128;
    const int it = w >> 1, cp = w & 1;
    const bf16* Wa = (const bf16*)(p.ws + OFF_WA) + (size_t)(l * 4 + g) * 128 * 128;
    const bf16* gvT = (const bf16*)(p.ws + OFF_VT); const float* rstd = (const float*)(p.ws + OFF_SSV) + tb;
    const bf16* hb = (const bf16*)(p.ws + OFF_H); bf16* y = (bf16*)(p.ws + OFF_U3);
    f32x16 acc[2];
#pragma unroll
    for (int c = 0; c < 2; ++c)
#pragma unroll
        for (int i = 0; i < 16; ++i) acc[c][i] = 0.f;
    bf16x8 wf[8], raw[2][8]; f32x4 rs0[8], rs1[8]; float gn[2];
#pragma unroll
    for (int ci = 0; ci < 2; ++ci) gn[ci] = p.a_v_gain[l * 512 + g * 128 + (2 * cp + ci) * 32 + r];
#pragma unroll
    for (int s = 0; s < 8; ++s) {
        wf[s] = *(const bf16x8*)(Wa + (size_t)(it * 32 + r) * 128 + s * 16 + hh * 8);
        rs0[s] = *(const f32x4*)(rstd + s * 16 + hh * 8); rs1[s] = *(const f32x4*)(rstd + s * 16 + hh * 8 + 4);
#pragma unroll
        for (int ci = 0; ci < 2; ++ci) raw[ci][s] = *(const bf16x8*)(gvT + (size_t)(VT_AV + g * 128 + (2 * cp + ci) * 32 + r) * T + tb + s * 16 + hh * 8);
    }
#pragma unroll
    for (int s = 0; s < 8; ++s) {
        if (s < 4 || it >= 2) {
#pragma unroll
            for (int ci = 0; ci < 2; ++ci) {
                float bv[8];
#pragma unroll
                for (int j = 0; j < 4; ++j) { bv[j] = (float)raw[ci][s][j] * rs0[s][j] * gn[ci]; bv[4 + j] = (float)raw[ci][s][4 + j] * rs1[s][j] * gn[ci]; }
                acc[ci] = MFMA32(cvt8(bv), wf[s], acc[ci]);
            }
        }
    }
    const size_t t = (size_t)tb + it * 32 + r;
    const float bs = p.a_bs[(size_t)(l * 4 + g) * 128 + it * 32 + r];
    bf16x4 uv[2][4], zv[2][4];
#pragma unroll
    for (int ci = 0; ci < 2; ++ci)
#pragma unroll
        for (int g4 = 0; g4 < 4; ++g4) { const int col = g * 128 + (2 * cp + ci) * 32 + 8 * g4 + 4 * hh;
            uv[ci][g4] = *(const bf16x4*)(hb + t * LDH + H_AU + col); zv[ci][g4] = *(const bf16x4*)(hb + t * LDH + H_AZ + col); }
#pragma unroll
    for (int ci = 0; ci < 2; ++ci)
#pragma unroll
        for (int g4 = 0; g4 < 4; ++g4) {
            const int col = g * 128 + (2 * cp + ci) * 32 + 8 * g4 + 4 * hh;
            f32x4 ov;
#pragma unroll
            for (int e = 0; e < 4; ++e) ov[e] = gelu_t((float)uv[ci][g4][e]) * (acc[ci][4 * g4 + e] + bs) * silu_f((float)zv[ci][g4][e]);
            *(bf16x4*)(y + t * DM + col) = __builtin_convertvector(ov, bf16x4);
        }
}

DI void phase_mix(const Params& p, int l, int G, LAS unsigned char* lds, int wv) {
    const int tid = opaque_tid(wv), w = __builtin_amdgcn_readfirstlane(tid >> 6);
    const bf16* hb = (const bf16*)(p.ws + OFF_H); bf16* y = (bf16*)(p.ws + OFF_U3);
    const bf16* vT = (const bf16*)(p.ws + OFF_VT);
    unsigned* ctr = (unsigned*)(p.ws + OFF_CTL) + XB_CTR(l);
    volatile LAS unsigned* bc = (volatile LAS unsigned*)(lds + LDS_MISC) + 4;
    for (;;) {
        if (tid == 0) *bc = xb_add(ctr, 1u);
        __syncthreads();
        const int item = (int)*bc;
        __syncthreads();
        if (item >= 1792) break;
        int tq = tid; asm volatile("" : "+v"(tq));
        if (item < 256) {
            const int qb = 7 - (item >> 5), bh = item & 31, b = bh >> 2, hd = bh & 3, s0 = qb * 256 + 32 * w; const size_t t0 = (size_t)b * S + s0;
            AttnWave aw{(const bf16*)(p.ws + OFF_QC) + t0 * 768 + hd * 192, 768, hb + t0 * LDH + H_CZ + hd * 128, y + t0 * DM + 1024 + hd * 128, s0, 0, ((s0 >> 6) + 1) * 64, hd};
            attn_block<192, 128, 0>(lds, (const bf16*)(p.ws + OFF_KC) + (size_t)b * S * 768 + hd * 192, 768, (const bf16*)(p.ws + OFF_VCT) + (size_t)(hd * 128) * T + (size_t)b * S,
                                    0, (qb + 1) * 256, aw, nullptr, nullptr, tq, p, l, b);
        } else if (item < 768) {
            const int j = item - 256, qt = 63 - (j >> 3), b = j & 7, s0 = qt * 32, hd = w; const size_t t0 = (size_t)b * S + s0;
            AttnWave aw{hb + t0 * LDH + H_BQ + hd * 64, LDH, hb + t0 * LDH + H_BZ + hd * 64, y + t0 * DM + 512 + hd * 64, s0, 0, ((s0 >> 6) + 1) * 64, hd};
            attn_block<64, 64, 1>(lds, hb + (size_t)b * S * LDH + H_BK, LDH, vT + (size_t)VT_BV * T + (size_t)b * S, 0, ((s0 >> 6) + 1) * 64, aw,
                                  (const float*)(p.ws + OFF_T5), (const unsigned*)(p.ws + OFF_MASK) + t0 * 64, tq, p, l, b);
        } else if (item < 1280) {
            const int j = item - 768, qb = 7 - (j >> 6), bh = j & 63, b = bh >> 3, hd = bh & 7, s0 = qb * 256 + 32 * w, c = s0 >> 6; const size_t t0 = (size_t)b * S + s0;
            AttnWave aw{hb + t0 * LDH + H_DQ + hd * 64, LDH, hb + t0 * LDH + H_DZ + hd * 64, y + t0 * DM + 1536 + hd * 64, s0, (c > 8 ? c - 8 : 0) * 64, (c + 1) * 64, hd};
            const int c0 = qb * 4;
            attn_block<64, 64, 2>(lds, hb + (size_t)b * S * LDH + H_DK + hd * 64, LDH, vT + (size_t)(VT_DV + hd * 64) * T + (size_t)b * S, (c0 > 8 ? c0 - 8 : 0) * 64, (c0 + 4) * 64, aw,
                                  (const float*)(p.ws + OFF_DT) + (size_t)l * 8 * 264 + hd * 264, nullptr, tq, p, l, b);
        } else {
            mixA_item(p, l, item - 1280, tq);
        }
    }
}

DI void phase_select_post1(const Params& p, int l, int G, LAS unsigned char* lds, int wv) {
    const int tid = opaque_tid(wv), blk = blockIdx.x, w = __builtin_amdgcn_readfirstlane(tid >> 6), lane = tid & 63;
    const bf16* hb = (const bf16*)(p.ws + OFF_H); unsigned* mask = (unsigned*)(p.ws + OFF_MASK);
    unsigned* ctr = (unsigned*)(p.ws + OFF_CTL) + XB_CTR(2 + l);
    volatile LAS unsigned* bc = (volatile LAS unsigned*)(lds + LDS_MISC) + 4;
    const int fr = lane & 15, fq = lane >> 4;
    SelRegs R;
    if (tid == 0) *bc = xb_add(ctr, 1u);
    __syncthreads();
    int j = (int)*bc;
    __syncthreads();
    if (j < 1024) sel_load(R, hb, j & 7, 127 - (j >> 3), w, fr, fq);
    while (j < 1024) {
        if (tid == 0) *bc = xb_add(ctr, 1u);
        {
            const int b = j & 7, qg = 127 - (j >> 3);
            if (qg >= 16) sel_scores(R, hb, b, qg, (LAS float*)lds, w, fr, fq);
            __syncthreads();
            const int jn = (int)*bc;
            if (jn < 1024) sel_load(R, hb, jn & 7, 127 - (jn >> 3), w, fr, fq);
            sel_select(mask, b, qg, (LAS float*)lds, w, lane);
            __syncthreads();
            j = jn;
        }
    }
    while (j < 1408) {
        if (tid == 0) *bc = xb_add(ctr, 1u);
        {
            if (j < 1152) avnorm_item(p, j - 1024, (LAS float*)lds, tid);
            else { const int r0 = (j - 1152) * 64 + w * 8;
                int lq = lane; asm volatile("" : "+v"(lq));
                P1Gains pg; pg.sk = (float*)(p.ws + OFF_STATK) + (size_t)l * T * 4; { const int d0 = (lq & 7) * 8;
#pragma unroll
        for (int j = 0; j < 8; ++j) { pg.bq[j] = p.b_q_gain[l * 64 + d0 + j]; pg.dq[j] = p.d_q_gain[l * 64 + d0 + j]; pg.dk[j] = p.d_k_gain[l * 64 + d0 + j]; pg.bk[j] = p.b_k_gain[l * 64 + d0 + j]; pg.kr[j] = p.c_k_gain[l * 192 + 128 + d0 + j]; } }
#pragma unroll 1
                for (int i = 0; i < 8; i += 4) { const int tt[4] = {r0 + i, r0 + i + 1, r0 + i + 2, r0 + i + 3}; post1_rows<4>(p, pg, tt, lq); } }
            __syncthreads();
            const int jn = (int)*bc;
            __syncthreads();
            j = jn;
        }
    }
}
__global__ void __launch_bounds__(512, 2) fwd_mega(Params p) {
    extern __shared__ __attribute__((aligned(16))) unsigned char lds_raw[];
    LAS unsigned char* lds = (LAS unsigned char*)lds_raw;
    cg::grid_group grid = cg::this_grid();
    const int G = gridDim.x, blk = blockIdx.x;
    const int wv = __builtin_amdgcn_readfirstlane(threadIdx.x >> 6);
    volatile LAS unsigned* misc = (volatile LAS unsigned*)(lds + LDS_MISC);
    if (threadIdx.x < 8) misc[threadIdx.x] = 0u;
    __syncthreads();
    XcdBarrier bar = xcd_barrier_post((unsigned*)(p.ws + OFF_CTL), misc, threadIdx.x == 0);
#define SEAM() xcd_barrier(bar, wv)
    phase_prep(p, lds, G, wv);
    if (G > (1 << 24)) grid.sync();
    SEAM();
#pragma unroll 1
    for (int l = 0; l < 2; ++l) {
        {
            Sched1 S1{blk, G, 64 + 26 * l, l == 0 ? 1664 : 1536};
            Epi1 E1{(bf16*)(p.ws + OFF_H), (bf16*)(p.ws + OFF_U2), (bf16*)(p.ws + OFF_VT), 64 + 26 * l, (float*)(p.ws + OFF_STATL) + (size_t)l * T * 2, (const float*)(p.ws + OFF_STATX) + (size_t)l * T};
            pg8::Gemm g1{(const pg8::bf16_t*)(p.ws + OFF_U1), (const pg8::bf16_t*)(p.ws + OFF_U1), 2048};
            pg8::gemm_phase<Epi1, Sched1, G_ALIGN, G_SP2>(lds, g1, S1, E1, wv);
            if (l == 1) { Sched1H S1h{blk, G, 64 + 26 * l}; pg8::gemm_phase<Epi1, Sched1H, G_ALIGN, G_SP2, true>(lds, g1, S1h, E1, wv); }
            if (l == 0) { int Gq = G; asm volatile("" : "+s"(Gq));
                const int nfull = 1664 % Gq, nidle = Gq - nfull;
                if (nfull > 0 && blk >= nfull) prep_weights(p, 1, (LAS float*)lds, blk - nfull, nidle, opaque_tid(wv));
                else if (nfull == 0) prep_weights(p, 1, (LAS float*)lds, blk, G, opaque_tid(wv)); }
        }
        SEAM();
        {
            Sched2 S2{blk, G, 64 + 7 * l};
            Epi2 E2{(bf16*)(p.ws + OFF_QC), (bf16*)(p.ws + OFF_KC), (bf16*)(p.ws + OFF_VCT), (const float*)(p.ws + OFF_STATL) + (size_t)l * T * 2, 64 + 7 * l, (float*)(p.ws + OFF_STATK) + (size_t)l * T * 4, (float*)(p.ws + OFF_STATQ) + (size_t)l * T * 4, p.c_q_gain + l * 192, p.c_k_gain + l * 192};
            pg8::Gemm g2{(const pg8::bf16_t*)(p.ws + OFF_U2), (const pg8::bf16_t*)(p.ws + OFF_U2), 512};
            pg8::gemm_phase<Epi2, Sched2, G_ALIGN, G_SP2>(lds, g2, S2, E2, wv);
        }
        phase_select_post1(p, l, G, lds, wv);
        SEAM();
        phase_mix(p, l, G, lds, wv);
        SEAM();
        {
            Sched3 S3{blk, G, 64 + 8 * l};
            pg8::Gemm g3{(const pg8::bf16_t*)(p.ws + OFF_U3), (const pg8::bf16_t*)(p.ws + OFF_U3), 2048};
            if (l == 0) { Epi3<true> E3{p.x, nullptr, nullptr, (bf16*)(p.ws + OFF_U1), (float*)(p.ws + OFF_STATX) + T, 64 + 8 * l};
                pg8::gemm_phase<Epi3<true>, Sched3, G_ALIGN, G_SP2>(lds, g3, S3, E3, wv); }
            else { Epi3<false> E3{nullptr, (const bf16*)(p.ws + OFF_U1), p.out, nullptr, nullptr, 64 + 8 * l};
                pg8::gemm_phase<Epi3<false>, Sched3, G_ALIGN, G_SP2>(lds, g3, S3, E3, wv); }
        }
        if (l == 0) SEAM();
    }
}

extern "C" void kernel_launch(void* const* d_in, const int* in_sizes, int n_in, void* d_out, int out_size, void* d_ws, size_t ws_size, hipStream_t stream) {
    static int grid_blocks = 0;
    if (!grid_blocks) {
        int dev = 0, cus = 0, per_cu = 0;
        hipGetDevice(&dev);
        hipDeviceGetAttribute(&cus, hipDeviceAttributeMultiprocessorCount, dev);
        hipFuncSetAttribute((const void*)fwd_mega, hipFuncAttributeMaxDynamicSharedMemorySize, (int)LDS_BYTES);
        hipOccupancyMaxActiveBlocksPerMultiprocessor(&per_cu, fwd_mega, 512, LDS_BYTES);
        if (per_cu > 1) per_cu = 1;
        grid_blocks = cus * per_cu;
        if (grid_blocks <= 0 || ws_size < WS_NEED) fprintf(stderr, "bad config: grid %d ws %zu need %zu\n", grid_blocks, ws_size, (size_t)WS_NEED);
    }
    Params p{};
    p.x = (const float*)d_in[0]; p.t5_bias = (const float*)d_in[1]; p.norm_g = (const float*)d_in[2]; p.w_in = (const float*)d_in[3];
    p.a_v_gain = (const float*)d_in[4]; p.a_ws = (const float*)d_in[5]; p.a_bs = (const float*)d_in[6]; p.b_q_gain = (const float*)d_in[7];
    p.b_k_gain = (const float*)d_in[8]; p.c_qa_gain = (const float*)d_in[9]; p.c_kva_gain = (const float*)d_in[10]; p.c_w_qb = (const float*)d_in[11];
    p.c_w_kvb = (const float*)d_in[12]; p.c_q_gain = (const float*)d_in[13]; p.c_k_gain = (const float*)d_in[14]; p.d_q_gain = (const float*)d_in[15];
    p.d_k_gain = (const float*)d_in[16]; p.d_rel_bias = (const float*)d_in[17]; p.w_out = (const float*)d_in[18];
    p.out = (float*)d_out; p.ws = (unsigned char*)d_ws;
    hipMemsetAsync((unsigned char*)d_ws + OFF_CTL, 0, CTL_BYTES, stream);
    void* args[] = {&p};
    hipError_t e = hipLaunchCooperativeKernel((void*)fwd_mega, dim3(grid_blocks), dim3(512), args, LDS_BYTES, stream);
    if (e != hipSuccess) fprintf(stderr, "cooperative launch failed: %s (grid %d)\n", hipGetErrorString(e), grid_blocks);
}
```

```cpp
#include <hip/hip_runtime.h>
#include <hip/hip_cooperative_groups.h>
#include <cstdio>
#include <cstdint>
namespace cg = cooperative_groups;

#define G_ALIGN true
#define G_SP2 true
#define DI __device__ __forceinline__
#define LAS __attribute__((address_space(3)))
typedef __bf16 bf16;
typedef __bf16 bf16x8 __attribute__((ext_vector_type(8)));
typedef __bf16 bf16x4 __attribute__((ext_vector_type(4)));
typedef float f32x4 __attribute__((ext_vector_type(4)));
typedef float f32x8 __attribute__((ext_vector_type(8)));
typedef float f32x16 __attribute__((ext_vector_type(16)));
typedef unsigned u32x4 __attribute__((ext_vector_type(4)));
typedef unsigned u32x2 __attribute__((ext_vector_type(2)));

constexpr int T = 16384, S = 2048, NBATCH = 8, DM = 2048, INC = 6408;
constexpr int LDH = 4864;
constexpr int H_AU = 0, H_AZ = 512, H_BQ = 1024, H_BIQ = 1536, H_BZ = 2048, H_CZ = 2560, H_DQ = 3072, H_DK = 3584, H_DZ = 4096,
              H_BK = 4608, H_BIK = 4672, H_CKR = 4736, H_BIW = 4800;
constexpr int VT_AV = 0, VT_DV = 512, VT_BV = 1024;
constexpr float EPS = 1e-6f, LOG2E = 1.4426950408889634f;
constexpr float SCALE_64 = 0.125f * LOG2E;
constexpr float SCALE_192 = 0.07216878364870322f * LOG2E;
constexpr float C_IW = 0.04419417382415922f;
constexpr int SCLD = 2052;
constexpr int LDS_MISC = 16 * SCLD * 4;
constexpr size_t LDS_BYTES = LDS_MISC + 256;

constexpr size_t MiB = 1048576;
constexpr size_t OFF_U1 = 0;
constexpr size_t OFF_U2 = OFF_U1 + 116 * MiB;
constexpr size_t OFF_U3 = OFF_U2 + 78 * (MiB / 4);
constexpr size_t OFF_H = OFF_U3 + 80 * MiB;
constexpr size_t OFF_VT = OFF_H + (size_t)T * LDH * 2;
constexpr size_t OFF_QC = OFF_VT + (size_t)1280 * T * 2;
constexpr size_t OFF_KC = OFF_QC + (size_t)T * 768 * 2;
constexpr size_t OFF_VCT = OFF_KC + (size_t)T * 768 * 2;
constexpr size_t OFF_MASK = OFF_VCT + (size_t)512 * T * 2;
constexpr size_t OFF_STATS = OFF_MASK + (size_t)T * 64 * 4;
constexpr size_t OFF_SSV = OFF_STATS + (size_t)T * 2 * 4;
constexpr size_t OFF_WA = OFF_SSV + (size_t)T * 4;
constexpr size_t OFF_COS = OFF_WA + 2 * 4 * 128 * 128 * 2;
constexpr size_t OFF_SIN = OFF_COS + 2048 * 32 * 4;
constexpr size_t OFF_T5 = OFF_SIN + 2048 * 32 * 4;
constexpr size_t OFF_DT = OFF_T5 + 8 * 2112 * 4;
constexpr size_t OFF_CTL = OFF_DT + 2 * 8 * 264 * 4;
constexpr size_t CTL_BYTES = 16384;
constexpr size_t OFF_STATK = OFF_CTL + CTL_BYTES;
constexpr size_t OFF_STATL = OFF_STATK + (size_t)2 * T * 4 * 4;
constexpr size_t OFF_STATX = OFF_STATL + (size_t)2 * T * 2 * 4;
constexpr size_t OFF_STATQ = OFF_STATX + (size_t)2 * T * 4;
constexpr size_t WS_NEED = OFF_STATQ + (size_t)2 * T * 4 * 4;

struct Params {
    const float* x; const float* t5_bias; const float* norm_g; const float* w_in; const float* a_v_gain; const float* a_ws; const float* a_bs;
    const float* b_q_gain; const float* b_k_gain; const float* c_qa_gain; const float* c_kva_gain; const float* c_w_qb; const float* c_w_kvb;
    const float* c_q_gain; const float* c_k_gain; const float* d_q_gain; const float* d_k_gain; const float* d_rel_bias; const float* w_out;
    float* out; unsigned char* ws;
};

DI int lane_id() { int t; asm volatile("v_mbcnt_lo_u32_b32 %0, -1, 0\n\tv_mbcnt_hi_u32_b32 %0, -1, %0" : "=v"(t)); return t; }
DI int opaque_tid(int wv) { return (wv << 6) | lane_id(); }
DI float fexp2(float x) { return __builtin_amdgcn_exp2f(x); }
DI float frcp(float x) { return __builtin_amdgcn_rcpf(x); }
DI float frsq(float x) { return __builtin_amdgcn_rsqf(x); }
DI float gelu_t(float x) { const float a = 0.7978845608028654f * (x + 0.044715f * x * x * x); return x * frcp(1.f + fexp2(-2.f * LOG2E * a)); }
DI float silu_f(float z) { return z * frcp(1.f + fexp2(-LOG2E * z)); }
DI bf16x8 cvt8(const float (&v)[8]) { f32x8 t; for (int j = 0; j < 8; ++j) t[j] = v[j]; return __builtin_convertvector(t, bf16x8); }
DI float shx(float v, int m) { return __shfl_xor(v, m); }
template <int CTRL> DI float dppf(float v) { return __int_as_float(__builtin_amdgcn_update_dpp(0, __float_as_int(v), CTRL, 0xF, 0xF, true)); }
#define DPP_XOR1 0xB1
#define DPP_XOR2 0x4E
#define DPP_XOR8 0x128
DI float dpp_xor4(float v) {
    int r = __builtin_amdgcn_update_dpp(0, __float_as_int(v), 0x104, 0xF, 0x5, false);
    r = __builtin_amdgcn_update_dpp(r, __float_as_int(v), 0x114, 0xF, 0xA, false);
    return __int_as_float(r); }
DI float sum8(float s) { s += dppf<DPP_XOR1>(s); s += dppf<DPP_XOR2>(s); s += dpp_xor4(s); return s; }
DI float xrow_sum(float x) { auto r = __builtin_amdgcn_permlane16_swap(__float_as_uint(x), __float_as_uint(x), false, false); return __uint_as_float(r[0]) + __uint_as_float(r[1]); }
DI float xhalf_max(float x) { auto r = __builtin_amdgcn_permlane32_swap(__float_as_uint(x), __float_as_uint(x), false, false); return fmaxf(__uint_as_float(r[0]), __uint_as_float(r[1])); }
DI float xhalf_sum(float x) { auto r = __builtin_amdgcn_permlane32_swap(__float_as_uint(x), __float_as_uint(x), false, false); return __uint_as_float(r[0]) + __uint_as_float(r[1]); }
DI float relu_i(float x) { const int b = __float_as_int(x); return __int_as_float(b > 0 ? b : 0); }
DI int crow(int reg, int h) { return (reg & 3) + 8 * (reg >> 2) + 4 * h; }
#define MFMA32(a, b, c) __builtin_amdgcn_mfma_f32_32x32x16_bf16((a), (b), (c), 0, 0, 0)
#define MFMA16(a, b, c) __builtin_amdgcn_mfma_f32_16x16x32_bf16((a), (b), (c), 0, 0, 0)


#define XB_TMO      128
#define XB_XCNT(j)  (256  + 64 * (j))
#define XB_XSUB(j)  (1280 + 64 * (j))
#define XB_XGEN(j)  (2304 + 64 * (j))
#define XB_TOP      3328
#define XB_TOPGEN   3392
#define XCD_BAR_WORDS 3456
#define XB_CTR(j)   (3520 + 64 * (j))
#define XB_SPIN_CAP (1u << 18)
DI unsigned xb_ld(unsigned* p)              { return __hip_atomic_load(p, __ATOMIC_RELAXED, __HIP_MEMORY_SCOPE_AGENT); }
DI unsigned xb_add(unsigned* p, unsigned v) { return __hip_atomic_fetch_add(p, v, __ATOMIC_RELAXED, __HIP_MEMORY_SCOPE_AGENT); }
DI unsigned xb_xcc_id() { return (unsigned)__builtin_amdgcn_s_getreg((3 << 11) | 20) & 0xFu; }
#define XB_SPIN(cond, bar) do { unsigned _sp = 0; while (cond) { __builtin_amdgcn_s_sleep(1); \
    if ((++_sp & 255u) == 0u) { if (xb_ld(&(bar)[XB_TMO])) break; if (_sp > XB_SPIN_CAP) { atomicAdd(&(bar)[XB_TMO], 1u); break; } } } } while (0)
struct XcdBarrier { unsigned* bar; unsigned x; volatile LAS unsigned* st; };
DI XcdBarrier xcd_barrier_post(unsigned* bar, volatile LAS unsigned* st, bool leader) {
    XcdBarrier b; b.bar = bar; b.x = xb_xcc_id(); b.st = st;
    if (leader) (void)xb_add(&bar[XB_XCNT(b.x)], 1u);
    return b;
}
DI void xcd_barrier_complete(unsigned* bar, unsigned x, unsigned& nloc, unsigned& nx) {
    const unsigned G = gridDim.x * gridDim.y * gridDim.z;
    unsigned sum, cnt, mine, sp = 0u;
    for (;;) {
        sum = 0u; cnt = 0u; mine = 0u;
#pragma unroll
        for (unsigned j = 0; j < 16; ++j) { const unsigned c = xb_ld(&bar[XB_XCNT(j)]); sum += c; cnt += (c > 0u) ? 1u : 0u; mine = (j == x) ? c : mine; }
        if (sum == G) break;
        __builtin_amdgcn_s_sleep(1);
        if ((++sp & 255u) == 0u) { if (xb_ld(&bar[XB_TMO])) break; if (sp > XB_SPIN_CAP) { atomicAdd(&bar[XB_TMO], 1u); break; } }
    }
    nloc = mine > 0u ? mine : 1u; nx = cnt > 0u ? cnt : 1u;
}
DI void xcd_barrier(const XcdBarrier& b, int wv) {
    asm volatile("s_waitcnt vmcnt(0)" ::: "memory");
    __syncthreads();
    if (wv == 0 && lane_id() == 0) {
        unsigned* bar = b.bar;
        unsigned bx = b.x; asm volatile("" : "+s"(bx));
        __builtin_amdgcn_s_waitcnt(0);
        unsigned nloc = b.st[0], nx = b.st[1];
        if (nloc == 0u) { xcd_barrier_complete(bar, bx, nloc, nx); b.st[0] = nloc; b.st[1] = nx; }
        const unsigned old = xb_add(&bar[XB_XSUB(bx)], 1u);
        const unsigned gen = old / nloc;
        if (old + 1u == (gen + 1u) * nloc) {
            __builtin_amdgcn_fence(__ATOMIC_RELEASE, "agent");
            asm volatile("s_waitcnt vmcnt(0)" ::: "memory");
            const unsigned og = xb_add(&bar[XB_TOP], 1u);
            const unsigned tg = og / nx;
            if (og + 1u == (tg + 1u) * nx) xb_add(&bar[XB_TOPGEN], 1u);
            else XB_SPIN(xb_ld(&bar[XB_TOPGEN]) == tg, bar);
            __builtin_amdgcn_fence(__ATOMIC_ACQUIRE, "agent");
            xb_add(&bar[XB_XGEN(bx)], 1u);
            asm volatile("s_waitcnt vmcnt(0)" ::: "memory");
        } else {
            XB_SPIN(xb_ld(&bar[XB_XGEN(bx)]) == gen, bar);
            __builtin_amdgcn_fence(__ATOMIC_ACQUIRE, "agent");
            asm volatile("s_waitcnt vmcnt(0)" ::: "memory");
        }
    }
    __syncthreads();
}

namespace pg8 {
typedef unsigned short bf16_t;
typedef short s16x8 __attribute__((ext_vector_type(8)));
constexpr int BM = 256, BK = 64, HALF = 128, HTB = HALF * BK * 2, STAGE_BYTES = 8 * HTB;
__host__ __device__ __forceinline__ int lds_byte(int r, int c) { const int st = (r >> 4) * 2 + (c >> 5), rr = r & 15, cc = c & 31, ob = rr * 64 + cc * 2; return st * 1024 + (ob ^ (((ob >> 9) & 1) << 5)); }
__host__ __device__ __forceinline__ void stage_rc(int b, int& R, int& C) { const int st = b / 1024, sb = b % 1024, swz = sb ^ (((sb >> 9) & 1) << 5); R = (st >> 1) * 16 + swz / 64; C = (st & 1) * 32 + (swz % 64) / 2; }
__host__ __device__ __forceinline__ int perm32(int rho) { const int n = rho >> 4, i = rho & 15; return 8 * (i >> 2) + 4 * n + (i & 3); }
struct Unit { int pm, pn, koff, nt, half; };
struct Gemm { const bf16_t* A; const bf16_t* Bt; int K; };

template <class Epi, class Sched, bool ALIGN_EPI = false, bool SP2 = false, bool HALFU = false>
__device__ __forceinline__ void gemm_phase(LAS unsigned char* lds, const Gemm g, const Sched& S, const Epi& E, int wv) {
    const int tid = opaque_tid(wv), wid = __builtin_amdgcn_readfirstlane(tid >> 6), lane = tid & 63, wr = wid >> 2, wc = wid & 3, fr = lane & 15, fq = lane >> 4;
    const int K = g.K;
    unsigned voffA[2], voffB[2];
#pragma unroll
    for (int i = 0; i < 2; ++i) { int R, C; stage_rc(tid * 16 + i * 8192, R, C); const int Rb = Epi::PERM ? ((R & ~31) + perm32(R & 31)) : R;
        voffA[i] = (unsigned)(R * K + C) * 2u; voffB[i] = (unsigned)(Rb * K + C) * 2u; }
    const size_t kstep = (size_t)(BK * 2);
    const size_t hstep = (size_t)HALF * K * 2;
    const size_t tstep = 2 * hstep;
    const unsigned ldsw = (unsigned)wid * 1024u;
    const int aoff = lds_byte(wr * 64 + fr, fq * 8), boff = lds_byte(wc * 32 + fr, fq * 8);
#define PG8_SA(b, h) (((b) * 2 + (h)) * HTB)
#define PG8_SB(b, h) ((4 + (b) * 2 + (h)) * HTB)
#define PG8_STAGE(bufoff, gbase, voff) do { _Pragma("unroll") for (int _i = 0; _i < 2; ++_i) \
        __builtin_amdgcn_global_load_lds((const unsigned*)((const char*)(gbase) + (voff)[_i]), (LAS unsigned*)(lds + (bufoff) + ldsw + _i * 8192), 16, 0, 0); } while (0)
#define PG8_LDA(dst, b, h) do { _Pragma("unroll") for (int m = 0; m < 4; ++m) _Pragma("unroll") for (int k = 0; k < 2; ++k) dst[m][k] = *(const LAS s16x8*)(lds + PG8_SA(b, h) + aoff + m * 2048 + k * 1024); } while (0)
#define PG8_LDB(dst, b, h) do { _Pragma("unroll") for (int n = 0; n < 2; ++n) _Pragma("unroll") for (int k = 0; k < 2; ++k) dst[n][k] = *(const LAS s16x8*)(lds + PG8_SB(b, h) + boff + n * 2048 + k * 1024); } while (0)
#define PG8_MMA(ai, bj, At, Bt) do { __builtin_amdgcn_s_setprio(1); _Pragma("unroll") for (int m = 0; m < 4; ++m) _Pragma("unroll") for (int n = 0; n < 2; ++n) _Pragma("unroll") for (int k = 0; k < 2; ++k) \
        acc[ai][bj][m][n] = __builtin_amdgcn_mfma_f32_16x16x32_bf16(Bt[n][k], At[m][k], acc[ai][bj][m][n], 0, 0, 0); __builtin_amdgcn_s_setprio(0); } while (0)
#define PG8_WAIT_V(n) asm volatile("s_waitcnt vmcnt(" #n ")" ::: "memory")
#define PG8_WAIT_L(n) asm volatile("s_waitcnt lgkmcnt(" #n ")" ::: "memory")
#define PG8_BAR __builtin_amdgcn_s_barrier()
#define PG8_SCHED __builtin_amdgcn_sched_barrier(0)
    Unit cur, nxt; int ui = 0;
    if (!S.next(0, cur)) return;
    f32x4 acc[2][2][4][2];
#pragma unroll
    for (int a = 0; a < 2; ++a)
#pragma unroll
        for (int b = 0; b < 2; ++b)
#pragma unroll
            for (int m = 0; m < 4; ++m)
#pragma unroll
                for (int n = 0; n < 2; ++n) acc[a][b][m][n] = (f32x4){0.f, 0.f, 0.f, 0.f};
    s16x8 At[4][2], B0[2][2], B1[2][2];
    const char* cA = (const char*)g.A + (size_t)cur.pm * tstep + cur.koff + (HALFU && cur.half == 2 ? hstep : 0); const char* cB = (const char*)g.Bt + (size_t)cur.pn * tstep + cur.koff;
    if constexpr (SP2) {
        PG8_STAGE(PG8_SB(0, 0), cB, voffB); PG8_STAGE(PG8_SB(0, 1), cB + hstep, voffB); PG8_STAGE(PG8_SA(0, 0), cA, voffA); PG8_STAGE(PG8_SA(0, 1), cA + hstep, voffA);
        if (wr == 1) PG8_BAR;
        PG8_WAIT_V(2); PG8_BAR;
        PG8_STAGE(PG8_SB(1, 0), cB + kstep, voffB); PG8_STAGE(PG8_SA(1, 0), cA + kstep, voffA); PG8_STAGE(PG8_SB(1, 1), cB + hstep + kstep, voffB);
        PG8_WAIT_V(6); PG8_BAR;
    } else {
        PG8_STAGE(PG8_SB(0, 0), cB, voffB); PG8_STAGE(PG8_SA(0, 0), cA, voffA); PG8_STAGE(PG8_SB(0, 1), cB + hstep, voffB); PG8_STAGE(PG8_SA(0, 1), cA + hstep, voffA);
        if (wr == 1) PG8_BAR;
        PG8_WAIT_V(4); PG8_BAR;
        PG8_STAGE(PG8_SB(1, 0), cB + kstep, voffB); PG8_STAGE(PG8_SA(1, 0), cA + kstep, voffA); PG8_STAGE(PG8_SB(1, 1), cB + hstep + kstep, voffB);
        PG8_WAIT_V(6); PG8_BAR;
    }
    for (;;) {
        const bool has_next = S.next(ui + 1, nxt);
        const char* nA = has_next ? (const char*)g.A + (size_t)nxt.pm * tstep + nxt.koff + (HALFU && nxt.half == 2 ? hstep : 0) : cA; const char* nB = has_next ? (const char*)g.Bt + (size_t)nxt.pn * tstep + nxt.koff : cB;
        const int nt = cur.nt; constexpr bool hf = HALFU;
        for (int t = 0; t < nt; t += 2) {
            const bool last = (t == nt - 2);
            const char* a1 = cA + (size_t)(t + 1) * kstep;
            const char* a2 = last ? nA : cA + (size_t)(t + 2) * kstep; const char* b2 = last ? nB : cB + (size_t)(t + 2) * kstep;
            const char* a3 = a2 + kstep; const char* b3 = b2 + kstep;
            if constexpr (SP2) {
            PG8_LDB(B0, 0, 0); PG8_LDB(B1, 0, 1); PG8_SCHED; PG8_LDA(At, 0, 0); PG8_STAGE(PG8_SA(1, 1), a1 + hstep, voffA);
            PG8_WAIT_V(8); PG8_WAIT_L(0); PG8_BAR; PG8_MMA(0, 0, At, B0); PG8_MMA(0, 1, At, B1); PG8_BAR; PG8_SCHED;
            if (!hf) PG8_LDA(At, 0, 1); PG8_STAGE(PG8_SB(0, 0), b2, voffB); PG8_STAGE(PG8_SB(0, 1), b2 + hstep, voffB); PG8_STAGE(PG8_SA(0, 0), a2, voffA);
            PG8_WAIT_V(8); PG8_WAIT_L(0); PG8_BAR; if (!hf) { PG8_MMA(1, 0, At, B0); PG8_MMA(1, 1, At, B1); } PG8_BAR; PG8_SCHED;
            PG8_LDB(B0, 1, 0); PG8_LDB(B1, 1, 1); PG8_SCHED; PG8_LDA(At, 1, 0); PG8_STAGE(PG8_SA(0, 1), a2 + hstep, voffA);
            PG8_WAIT_V(8); PG8_WAIT_L(0); PG8_BAR; PG8_MMA(0, 0, At, B0); PG8_MMA(0, 1, At, B1); PG8_BAR; PG8_SCHED;
            if (!hf) PG8_LDA(At, 1, 1); PG8_STAGE(PG8_SB(1, 0), b3, voffB); PG8_STAGE(PG8_SB(1, 1), b3 + hstep, voffB); PG8_STAGE(PG8_SA(1, 0), a3, voffA);
            PG8_WAIT_V(8); PG8_WAIT_L(0); PG8_BAR; if (!hf) { PG8_MMA(1, 0, At, B0); PG8_MMA(1, 1, At, B1); } PG8_BAR; PG8_SCHED;
            } else {
            PG8_LDB(B0, 0, 0); PG8_SCHED; PG8_LDA(At, 0, 0); PG8_STAGE(PG8_SA(1, 1), a1 + hstep, voffA);
            PG8_WAIT_L(8); PG8_BAR; PG8_WAIT_L(0); PG8_MMA(0, 0, At, B0); PG8_BAR; PG8_SCHED;
            PG8_LDB(B1, 0, 1); PG8_STAGE(PG8_SB(0, 0), b2, voffB);
            PG8_BAR; PG8_WAIT_L(0); PG8_MMA(0, 1, At, B1); PG8_BAR;
            PG8_LDA(At, 0, 1); PG8_STAGE(PG8_SA(0, 0), a2, voffA);
            PG8_BAR; PG8_WAIT_L(0); PG8_MMA(1, 0, At, B0); PG8_BAR; PG8_SCHED;
            PG8_STAGE(PG8_SB(0, 1), b2 + hstep, voffB);
            PG8_WAIT_V(6); PG8_BAR; PG8_MMA(1, 1, At, B1); PG8_BAR;
            PG8_LDB(B0, 1, 0); PG8_SCHED; PG8_LDA(At, 1, 0); PG8_STAGE(PG8_SA(0, 1), a2 + hstep, voffA);
            PG8_WAIT_L(8); PG8_BAR; PG8_WAIT_L(0); PG8_MMA(0, 0, At, B0); PG8_BAR; PG8_SCHED;
            PG8_LDB(B1, 1, 1); PG8_STAGE(PG8_SB(1, 0), b3, voffB);
            PG8_BAR; PG8_WAIT_L(0); PG8_MMA(0, 1, At, B1); PG8_BAR;
            PG8_LDA(At, 1, 1); PG8_STAGE(PG8_SA(1, 0), a3, voffA);
            PG8_BAR; PG8_WAIT_L(0); PG8_MMA(1, 0, At, B0); PG8_BAR; PG8_SCHED;
            PG8_STAGE(PG8_SB(1, 1), b3 + hstep, voffB);
            PG8_WAIT_V(6); PG8_BAR; PG8_MMA(1, 1, At, B1); PG8_BAR;
            }
        }
        if constexpr (ALIGN_EPI) { if (wr == 0) PG8_BAR; }
        E(acc, cur, wr, wc, fr, fq);
        if (!has_next) break;
#pragma unroll
        for (int a = 0; a < 2; ++a)
#pragma unroll
            for (int b = 0; b < 2; ++b)
#pragma unroll
                for (int m = 0; m < 4; ++m)
#pragma unroll
                    for (int n = 0; n < 2; ++n) acc[a][b][m][n] = (f32x4){0.f, 0.f, 0.f, 0.f};
        cur = nxt; cA = nA; cB = nB; ++ui;
        if constexpr (ALIGN_EPI) { if (wr == 1) PG8_BAR; }
    }
    PG8_WAIT_V(0);
    if constexpr (!ALIGN_EPI) { if (wr == 0) PG8_BAR; }
    PG8_BAR;
#undef PG8_SA
#undef PG8_SB
#undef PG8_STAGE
#undef PG8_LDA
#undef PG8_LDB
#undef PG8_MMA
#undef PG8_WAIT_V
#undef PG8_WAIT_L
#undef PG8_BAR
#undef PG8_SCHED
}
}
using pg8::Unit;
typedef float f32x2 __attribute__((ext_vector_type(2)));

DI u32x4 pack8(const f32x4 a, const f32x4 b) {
    f32x8 t; t[0] = a[0]; t[1] = a[1]; t[2] = a[2]; t[3] = a[3]; t[4] = b[0]; t[5] = b[1]; t[6] = b[2]; t[7] = b[3];
    return __builtin_bit_cast(u32x4, __builtin_convertvector(t, bf16x8));
}

struct Sched1 {
    int c, G, wbase, nu;
    DI bool next(int i, Unit& u) const {
        const int L = i * G + c; if (L >= nu) return false;
        u.koff = 0; u.nt = 32; u.half = 0;
        if (L < 1344) { const int xcd = L & 7, off = L >> 3; u.pm = 8 * xcd + (off & 7); u.pn = wbase + (off >> 3); }
        else { const int Lp = L - 1344, xcd = Lp & 7, off = Lp >> 3; u.pn = 8 * xcd + (off & 7); u.pm = wbase + 21 + (off >> 3); }
        return true; }
};
struct Sched1H {
    int c, G, wbase;
    DI bool next(int i, Unit& u) const {
        const int h = i * G + c; if (h >= 256) return false;
        const int xcd = h & 7, q = h >> 3, off = 24 + (q >> 1);
        u.koff = 0; u.nt = 32; u.pn = 8 * xcd + (off & 7); u.pm = wbase + 21 + (off >> 3); u.half = 1 + (q & 1);
        return true; }
};
struct Sched2 {
    int c, G, wbase;
    DI bool next(int i, Unit& u) const {
        const int L = i * G + c; if (L >= 448) return false;
        u.half = 0;
        if (L < 320) { const int xcd = L & 7, off = L >> 3; u.pm = 8 * xcd + (off & 7); u.pn = wbase + (off >> 3); const bool isq = (off >> 3) < 3; u.koff = isq ? 0 : 384 * 2; u.nt = isq ? 6 : 2; }
        else { const int Lp = L - 320, xcd = Lp & 7, off = Lp >> 3; u.pn = 8 * xcd + (off & 7); u.pm = wbase + 5 + (off >> 3); u.koff = 384 * 2; u.nt = 2; }
        return true; }
};
struct Sched3 {
    int c, G, wbase;
    DI bool next(int i, Unit& u) const {
        const int L = i * G + c; if (L >= 512) return false;
        const int xcd = L & 7, off = L >> 3; u.pm = 8 * xcd + (off & 7); u.pn = wbase + (off >> 3); u.koff = 0; u.nt = 32; u.half = 0;
        return true; }
};

struct Epi1 {
    static constexpr bool PERM = true;
    bf16* h; bf16* lat; bf16* vT; int wbase; float* ssq;
    const float* rs;
    DI void operator()(const f32x4 (&acc)[2][2][4][2], const Unit& u, int wr, int wc, int fr, int fq) const {
        if (u.pm < 64) {
            const int wt = u.pn - wbase;
            bf16* O; int ldc, colt;
            if (wt < 19) { O = h; ldc = LDH; colt = wt * 256; } else { O = lat; ldc = 512; colt = (wt - 19) * 256; }
            const int row0 = u.pm * 256 + wr * 64 + fr, col0 = colt + wc * 32 + 8 * fq;
            float sc[2][4];
#pragma unroll
            for (int ai = 0; ai < 2; ++ai)
#pragma unroll
                for (int m = 0; m < 4; ++m) sc[ai][m] = frsq(rs[row0 + ai * 128 + m * 16] * (1.f / DM) + EPS);
#pragma unroll
            for (int ai = 0; ai < 2; ++ai)
#pragma unroll
                for (int m = 0; m < 4; ++m) { bf16* rowp = O + (size_t)(row0 + ai * 128 + m * 16) * ldc + col0;
#pragma unroll
                    for (int bj = 0; bj < 2; ++bj) *(u32x4*)(rowp + bj * 128) = pack8(acc[ai][bj][m][0] * sc[ai][m], acc[ai][bj][m][1] * sc[ai][m]); }
            if (wt >= 19) {
#pragma unroll
                for (int ai = 0; ai < 2; ++ai)
#pragma unroll
                    for (int m = 0; m < 4; ++m) { float s2[2];
#pragma unroll
                        for (int bj = 0; bj < 2; ++bj) { const f32x4 a = acc[ai][bj][m][0] * sc[ai][m], b = acc[ai][bj][m][1] * sc[ai][m];
                            float t = a[0] * a[0] + a[1] * a[1] + a[2] * a[2] + a[3] * a[3] + b[0] * b[0] + b[1] * b[1] + b[2] * b[2] + b[3] * b[3];
                            t = xrow_sum(t); t = xhalf_sum(t); s2[bj] = t; }
                        if (fq == 0) { float* sq = ssq + (size_t)(row0 + ai * 128 + m * 16) * 2;
                            if (wt == 19) __hip_atomic_fetch_add(sq, s2[0] + s2[1], __ATOMIC_RELAXED, __HIP_MEMORY_SCOPE_AGENT);
                            else { __hip_atomic_fetch_add(sq, s2[0], __ATOMIC_RELAXED, __HIP_MEMORY_SCOPE_AGENT); __hip_atomic_fetch_add(sq + 1, s2[1], __ATOMIC_RELAXED, __HIP_MEMORY_SCOPE_AGENT); } } }
            }
        } else {
            const int ft = u.pm - wbase - 21;
            const int na = u.half ? 1 : 2;
            const int f0 = ft * 256 + (u.half == 2 ? 128 : 0) + wr * 64 + fr, tok0 = u.pn * 256 + wc * 32 + 8 * fq;
            f32x4 scc[2][2];
#pragma unroll
            for (int bj = 0; bj < 2; ++bj)
#pragma unroll
                for (int n = 0; n < 2; ++n)
#pragma unroll
                    for (int e = 0; e < 4; ++e) scc[bj][n][e] = frsq(rs[tok0 + bj * 128 + n * 4 + e] * (1.f / DM) + EPS);
            if (ft < 2) {
#pragma unroll
                for (int ai = 0; ai < 2; ++ai) if (ai < na)
#pragma unroll
                    for (int m = 0; m < 4; ++m) { bf16* rowp = vT + (size_t)(f0 + ai * 128 + m * 16) * T + tok0;
#pragma unroll
                        for (int bj = 0; bj < 2; ++bj) { f32x4 v0 = acc[ai][bj][m][0] * scc[bj][0], v1 = acc[ai][bj][m][1] * scc[bj][1];
#pragma unroll
                            for (int e = 0; e < 4; ++e) { v0[e] = gelu_t(v0[e]); v1[e] = gelu_t(v1[e]); }
                            *(u32x4*)(rowp + bj * 128) = pack8(v0, v1); } }
            } else {
#pragma unroll
                for (int ai = 0; ai < 2; ++ai) if (ai < na)
#pragma unroll
                    for (int m = 0; m < 4; ++m) { bf16* rowp = vT + (size_t)(f0 + ai * 128 + m * 16) * T + tok0;
#pragma unroll
                        for (int bj = 0; bj < 2; ++bj) *(u32x4*)(rowp + bj * 128) = pack8(acc[ai][bj][m][0] * scc[bj][0], acc[ai][bj][m][1] * scc[bj][1]); }
            }
        }
    }
};
struct Epi2 {
    static constexpr bool PERM = true;
    bf16* qc; bf16* kC; bf16* vCT; const float* stats; int wbase; float* statk; float* statq; const float* gq; const float* gk;
    DI void operator()(const f32x4 (&acc)[2][2][4][2], const Unit& u, int wr, int wc, int fr, int fq) const {
        if (u.pm < 64) {
            const int wt = u.pn - wbase;
            const int row0 = u.pm * 256 + wr * 64 + fr;
            f32x4 gg[2][2];
            if (wt < 3) {
#pragma unroll
                for (int bj = 0; bj < 2; ++bj) { const int c0 = wt * 256 + bj * 128 + wc * 32 + 8 * fq, d0 = c0 % 192;
#pragma unroll
                    for (int n = 0; n < 2; ++n)
#pragma unroll
                        for (int e = 0; e < 4; ++e) gg[bj][n][e] = gq[d0 + n * 4 + e] * (d0 < 128 ? gk[d0 + n * 4 + e] : 1.f); } }
            float scv[2][4];
#pragma unroll
            for (int ai = 0; ai < 2; ++ai)
#pragma unroll
                for (int m = 0; m < 4; ++m) scv[ai][m] = stats[(row0 + ai * 128 + m * 16) * 2 + (wt < 3 ? 0 : 1)];
#pragma unroll
            for (int ai = 0; ai < 2; ++ai)
#pragma unroll
                for (int m = 0; m < 4; ++m) { const int row = row0 + ai * 128 + m * 16; const float sc = frsq(scv[ai][m] * (wt < 3 ? 1.f / 384.f : 1.f / 128.f) + EPS);
#pragma unroll
                    for (int bj = 0; bj < 2; ++bj) {
                        bf16* dst = (wt < 3) ? qc + (size_t)row * 768 + wt * 256 + bj * 128 + wc * 32 + 8 * fq
                                             : kC + (size_t)row * 768 + ((wt - 3) * 2 + bj) * 192 + wc * 32 + 8 * fq;
                        if (wt < 3) {
                            const f32x4 a = acc[ai][bj][m][0] * sc, b = acc[ai][bj][m][1] * sc;
                            *(u32x4*)dst = pack8(a * gg[bj][0], b * gg[bj][1]);
                            float t = a[0] * a[0] + a[1] * a[1] + a[2] * a[2] + a[3] * a[3] + b[0] * b[0] + b[1] * b[1] + b[2] * b[2] + b[3] * b[3];
                            t = xrow_sum(t); t = xhalf_sum(t);
                            if (fq == 0) __hip_atomic_fetch_add(statq + (size_t)row * 4 + (wt * 256 + bj * 128 + wc * 32) / 192, t, __ATOMIC_RELAXED, __HIP_MEMORY_SCOPE_AGENT);
                        } else
                        *(u32x4*)dst = pack8(acc[ai][bj][m][0] * sc, acc[ai][bj][m][1] * sc); }
                    if (wt >= 3) {
#pragma unroll
                        for (int bj = 0; bj < 2; ++bj) { const f32x4 a = acc[ai][bj][m][0] * sc, b = acc[ai][bj][m][1] * sc;
                            float t = a[0] * a[0] + a[1] * a[1] + a[2] * a[2] + a[3] * a[3] + b[0] * b[0] + b[1] * b[1] + b[2] * b[2] + b[3] * b[3];
                            t = xrow_sum(t); t = xhalf_sum(t);
                            if (fq == 0) __hip_atomic_fetch_add(statk + (size_t)row * 4 + (wt - 3) * 2 + bj, t, __ATOMIC_RELAXED, __HIP_MEMORY_SCOPE_AGENT); } } }
        } else {
            const int ft = u.pm - wbase - 5;
            const int f0 = ft * 256 + wr * 64 + fr, tok0 = u.pn * 256 + wc * 32 + 8 * fq;
            f32x4 sc[2][2];
#pragma unroll
            for (int bj = 0; bj < 2; ++bj)
#pragma unroll
                for (int n = 0; n < 2; ++n)
#pragma unroll
                    for (int e = 0; e < 4; ++e) sc[bj][n][e] = frsq(stats[(tok0 + bj * 128 + n * 4 + e) * 2 + 1] * (1.f / 128.f) + EPS);
#pragma unroll
            for (int ai = 0; ai < 2; ++ai)
#pragma unroll
                for (int m = 0; m < 4; ++m) { bf16* rowp = vCT + (size_t)(f0 + ai * 128 + m * 16) * T + tok0;
#pragma unroll
                    for (int bj = 0; bj < 2; ++bj) *(u32x4*)(rowp + bj * 128) = pack8(acc[ai][bj][m][0] * sc[bj][0], acc[ai][bj][m][1] * sc[bj][1]); }
        }
    }
};
template <bool L0>
struct Epi3 {
    static constexpr bool PERM = false;
    const float* xin; const bf16* xb; float* out; bf16* x1b; float* ssq1; int wbase;
    DI void operator()(const f32x4 (&acc)[2][2][4][2], const Unit& u, int wr, int wc, int fr, int fq) const {
        const int row0 = u.pm * 256 + wr * 64 + fr, col0 = (u.pn - wbase) * 256 + wc * 32 + 4 * fq;
#pragma unroll
        for (int ai = 0; ai < 2; ++ai)
#pragma unroll
            for (int mh = 0; mh < 2; ++mh) {
                if constexpr (L0) {
                    bf16x4 xv[2][2][2];
#pragma unroll
                    for (int m2 = 0; m2 < 2; ++m2) { const size_t ro = (size_t)(row0 + ai * 128 + (mh * 2 + m2) * 16) * DM + col0;
#pragma unroll
                        for (int bj = 0; bj < 2; ++bj)
#pragma unroll
                            for (int n = 0; n < 2; ++n) xv[m2][bj][n] = *(const bf16x4*)(x1b + ro + bj * 128 + n * 16); }
#pragma unroll
                    for (int m2 = 0; m2 < 2; ++m2) { const int row = row0 + ai * 128 + (mh * 2 + m2) * 16; const size_t ro = (size_t)row * DM + col0; float t = 0.f;
#pragma unroll
                        for (int bj = 0; bj < 2; ++bj)
#pragma unroll
                            for (int n = 0; n < 2; ++n) { const f32x4 v = __builtin_convertvector(xv[m2][bj][n], f32x4) + acc[ai][bj][mh * 2 + m2][n];
                                t += v[0] * v[0] + v[1] * v[1] + v[2] * v[2] + v[3] * v[3];
                                *(bf16x4*)(x1b + ro + bj * 128 + n * 16) = __builtin_convertvector(v, bf16x4); }
                        t = xrow_sum(t); t = xhalf_sum(t);
                        if (fq == 0) __hip_atomic_fetch_add(ssq1 + row, t, __ATOMIC_RELAXED, __HIP_MEMORY_SCOPE_AGENT); }
                } else {
                    bf16x4 xv[2][2][2];
#pragma unroll
                    for (int m2 = 0; m2 < 2; ++m2) { const size_t ro = (size_t)(row0 + ai * 128 + (mh * 2 + m2) * 16) * DM + col0;
#pragma unroll
                        for (int bj = 0; bj < 2; ++bj)
#pragma unroll
                            for (int n = 0; n < 2; ++n) xv[m2][bj][n] = *(const bf16x4*)(xb + ro + bj * 128 + n * 16); }
#pragma unroll
                    for (int m2 = 0; m2 < 2; ++m2) { const size_t ro = (size_t)(row0 + ai * 128 + (mh * 2 + m2) * 16) * DM + col0;
#pragma unroll
                        for (int bj = 0; bj < 2; ++bj)
#pragma unroll
                            for (int n = 0; n < 2; ++n) *(f32x4*)(out + ro + bj * 128 + n * 16) = __builtin_convertvector(xv[m2][bj][n], f32x4) + acc[ai][bj][mh * 2 + m2][n]; }
                }
            }
    }
};

struct TSub { const float* src; bf16* dst; int valid; };
DI void transpose_tile4(LAS float* lt, const TSub (&sub)[4], int src_ld, const float* gain, int dst_ld, int tid) {
    const int kk = tid >> 4, n4 = (tid & 15) * 4;
    f32x4 v[4][2];
#pragma unroll
    for (int q = 0; q < 4; ++q)
#pragma unroll
        for (int pass = 0; pass < 2; ++pass) {
            v[q][pass] = (f32x4){0.f, 0.f, 0.f, 0.f};
            if (sub[q].src && n4 < sub[q].valid) v[q][pass] = __builtin_nontemporal_load((const f32x4*)(sub[q].src + (size_t)(kk + 32 * pass) * src_ld + n4));
        }
    const float g0 = gain ? gain[kk] : 1.f, g1 = gain ? gain[kk + 32] : 1.f;
    const int n = tid >> 3, k8 = (tid & 7) * 8;
#pragma unroll
    for (int q = 0; q < 4; ++q) {
#pragma unroll
        for (int e = 0; e < 4; ++e) { lt[kk * 65 + n4 + e] = v[q][0][e] * g0; lt[(kk + 32) * 65 + n4 + e] = v[q][1][e] * g1; }
        __syncthreads();
        float o[8];
#pragma unroll
        for (int j = 0; j < 8; ++j) o[j] = lt[(k8 + j) * 65 + n];
        *(bf16x8*)(sub[q].dst + (size_t)n * dst_ld + k8) = cvt8(o);
        __syncthreads();
    }
}
DI int wi_orig(int n0, int& valid) {
    valid = 64;
    if (n0 < 512) return n0;
    if (n0 < 1024) return 1024 + (n0 - 512);
    if (n0 < 1536) return 1536 + (n0 - 1024);
    if (n0 < 2048) return 2176 + (n0 - 1536);
    if (n0 < 2560) return 2760 + (n0 - 2048);
    if (n0 < 3072) return 3848 + (n0 - 2560);
    if (n0 < 3584) return 4360 + (n0 - 3072);
    if (n0 < 4096) return 4872 + (n0 - 3584);
    if (n0 < 4608) return 5896 + (n0 - 4096);
    if (n0 == 4608) return 2048;
    if (n0 == 4672) return 2688;
    if (n0 == 4736) return 3784;
    if (n0 == 4800) { valid = 8; return 2752; }
    if (n0 < 5248) return 3272 + (n0 - 4864);
    if (n0 < 5376) return 3656 + (n0 - 5248);
    if (n0 < 5888) return 512 + (n0 - 5376);
    if (n0 < 6400) return 5384 + (n0 - 5888);
    if (n0 == 6400) return 2112;
    return -1;
}
DI int t5_bucket(int rel) {
    const int n = rel < 0 ? -rel : rel; const int ret = rel > 0 ? 16 : 0;
    int v; if (n < 8) v = n; else { v = 33 - __clz(n * n); if (v > 15) v = 15; }
    return ret + v;
}
DI void prep_x_rows(const float* xin, bf16* xb, unsigned char* ws, int gw, int nw, int lane) {
    float* statx = (float*)(ws + OFF_STATX); float* statl = (float*)(ws + OFF_STATL); float* statk = (float*)(ws + OFF_STATK); float* statq = (float*)(ws + OFF_STATQ);
    for (int row = gw; row < T; row += nw) {
        f32x4 v[8]; float ss = 0.f;
#pragma unroll
        for (int i = 0; i < 8; ++i) { v[i] = *(const f32x4*)(xin + (size_t)row * DM + i * 256 + lane * 4); ss += v[i][0] * v[i][0] + v[i][1] * v[i][1] + v[i][2] * v[i][2] + v[i][3] * v[i][3]; }
        ss = sum8(ss); ss += dppf<DPP_XOR8>(ss); ss = xrow_sum(ss); ss = xhalf_sum(ss);
#pragma unroll
        for (int i = 0; i < 8; ++i) *(bf16x4*)(xb + (size_t)row * DM + i * 256 + lane * 4) = __builtin_convertvector(v[i], bf16x4);
        if (lane == 0) { statx[row] = ss; statx[T + row] = 0.f; }
        if (lane < 4) { statl[(size_t)row * 4 + lane] = 0.f; statk[(size_t)row * 4 + lane] = 0.f; statk[(size_t)T * 4 + (size_t)row * 4 + lane] = 0.f;
            statq[(size_t)row * 4 + lane] = 0.f; statq[(size_t)T * 4 + (size_t)row * 4 + lane] = 0.f; }
    }
}
DI void prep_weights(const Params& p, int l, LAS float* lt, int j0, int step, int tid) {
    bf16* U1 = (bf16*)(p.ws + OFF_U1); bf16* U2 = (bf16*)(p.ws + OFF_U2); bf16* U3 = (bf16*)(p.ws + OFF_U3);
    for (int j = j0; j < 1144; j += step) {
        TSub sub[4];
        if (j < 832) {
            const int ntg = j >> 5, kt = j & 31;
#pragma unroll
            for (int q = 0; q < 4; ++q) { const int nt = ntg * 4 + q; int valid; const int oc = wi_orig(nt * 64, valid);
                sub[q].src = oc < 0 ? nullptr : p.w_in + (size_t)l * DM * INC + (size_t)(kt * 64) * INC + oc; sub[q].valid = valid;
                sub[q].dst = U1 + (size_t)(64 + 26 * l) * 256 * 2048 + (size_t)(nt * 64) * 2048 + kt * 64; }
            transpose_tile4(lt, sub, INC, p.norm_g + l * DM + kt * 64, 2048, tid);
        } else if (j < 1088) {
            const int jj = j - 832, ntg = jj >> 5, kt = jj & 31;
#pragma unroll
            for (int q = 0; q < 4; ++q) { const int nt = ntg * 4 + q;
                sub[q].src = p.w_out + (size_t)l * DM * DM + (size_t)(kt * 64) * DM + nt * 64; sub[q].valid = 64;
                sub[q].dst = U3 + (size_t)(64 + 8 * l) * 256 * 2048 + (size_t)(nt * 64) * 2048 + kt * 64; }
            transpose_tile4(lt, sub, DM, nullptr, 2048, tid);
        } else {
            const int jj = j - 1088, ntg = jj >> 3, kt = jj & 7;
            const bool isq = ntg < 3; const bool live = isq ? (kt < 6) : (kt >= 6);
#pragma unroll
            for (int q = 0; q < 4; ++q) { const int nt = ntg * 4 + q; const float* src = nullptr;
                if (live) { if (isq) src = p.c_w_qb + (size_t)l * 384 * 768 + (size_t)(kt * 64) * 768 + nt * 64;
                    else { const int np = (nt - 12) * 64; const int oc = np < 512 ? (np >> 7) * 256 + (np & 127) : ((np - 512) >> 7) * 256 + 128 + ((np - 512) & 127);
                        src = p.c_w_kvb + (size_t)l * 128 * 1024 + (size_t)((kt - 6) * 64) * 1024 + oc; } }
                sub[q].src = src; sub[q].valid = 64; sub[q].dst = U2 + (size_t)(64 + 7 * l) * 256 * 512 + (size_t)(nt * 64) * 512 + kt * 64; }
            const float* gain = !live ? nullptr : (isq ? p.c_qa_gain + l * 384 + kt * 64 : p.c_kva_gain + l * 128 + (kt - 6) * 64);
            transpose_tile4(lt, sub, isq ? 768 : 1024, gain, 512, tid);
        }
    }
}
DI void phase_prep(const Params& p, LAS unsigned char* lds, int G, int wv) {
    const int tid = opaque_tid(wv), blk = blockIdx.x;
    prep_weights(p, 0, (LAS float*)lds, blk, G, tid);
    bf16* U1 = (bf16*)(p.ws + OFF_U1);
    const int gt = blk * 512 + tid, nthr = G * 512;
    bf16* Wa = (bf16*)(p.ws + OFF_WA);
    for (int e = gt; e < 2 * 4 * 128 * 128; e += nthr) { const int jx = e & 127, ix = (e >> 7) & 127; Wa[e] = (bf16)(((jx >> 6) <= (ix >> 6)) ? p.a_ws[e] : 0.f); }
    float* ct = (float*)(p.ws + OFF_COS); float* st = (float*)(p.ws + OFF_SIN);
    for (int e = gt; e < 2048 * 32; e += nthr) { const int pos = e >> 5, i = e & 31; const float inv = exp2f(-(float)(2 * i) * (13.287712379549449f / 64.f)); const float ang = (float)pos * inv;
        ct[e] = cosf(ang); st[e] = sinf(ang); }
    float* t5 = (float*)(p.ws + OFF_T5);
    for (int e = gt; e < 8 * 2112; e += nthr) { const int hd = e / 2112, idx = e % 2112; t5[e] = p.t5_bias[t5_bucket(idx - 2047) * 8 + hd] * LOG2E; }
    float* dt = (float*)(p.ws + OFF_DT);
    for (int e = gt; e < 2 * 8 * 264; e += nthr) { const int l = e / (8 * 264), hd = (e / 264) & 7, i = e % 264; dt[e] = (i < 257) ? p.d_rel_bias[(size_t)l * 257 * 8 + i * 8 + hd] * LOG2E : 0.f; }
    prep_x_rows(p.x, U1, p.ws, (tid >> 6) * G + blk, 8 * G, tid & 63);
}

DI unsigned fkey(float f) { unsigned b = __float_as_uint(f); if (b == 0x80000000u) b = 0u; return (b & 0x80000000u) ? ~b : (b | 0x80000000u); }
DI unsigned wave_sum_u32(unsigned x) {
    x += (unsigned)__builtin_amdgcn_update_dpp(0, (int)x, 0xB1, 0xF, 0xF, true);
    x += (unsigned)__builtin_amdgcn_update_dpp(0, (int)x, 0x4E, 0xF, 0xF, true);
    x += (unsigned)__builtin_amdgcn_update_dpp(0, (int)x, 0x141, 0xF, 0xF, true);
    x += (unsigned)__builtin_amdgcn_update_dpp(0, (int)x, 0x140, 0xF, 0xF, true);
    return (unsigned)__builtin_amdgcn_readlane((int)x, 0) + (unsigned)__builtin_amdgcn_readlane((int)x, 16) + (unsigned)__builtin_amdgcn_readlane((int)x, 32) + (unsigned)__builtin_amdgcn_readlane((int)x, 48);
}
template <int NMX>
DI unsigned long long sel_ties(const unsigned (&u)[NMX], unsigned prefix, int lane) {
    unsigned long long myw = 0ull; int cgt = 0;
#pragma unroll
    for (int m = 0; m < NMX; ++m) cgt += __popcll(__ballot(u[m] > prefix));
    int need = 256 - cgt;
#pragma unroll
    for (int m = 0; m < NMX; ++m) {
        const unsigned long long gtm = __ballot(u[m] > prefix), eqm = __ballot(u[m] == prefix);
        const int ne = __popcll(eqm); const int take = need < ne ? need : ne; need -= take;
        const unsigned long long below = (lane == 0) ? 0ull : (~0ull >> (64 - lane));
        const bool sel = (u[m] == prefix) && (__popcll(eqm & below) < take);
        const unsigned long long bm = gtm | __ballot(sel);
        myw = (lane == m) ? bm : myw; }
    return myw;
}
template <int NMX>
DI void sel_rows2(const LAS float* row0, const LAS float* row1, int nm, int lane, unsigned long long& w0, unsigned long long& w1) {
    unsigned u0[NMX], u1[NMX];
#pragma unroll
    for (int m = 0; m < NMX; ++m) { u0[m] = (m < nm) ? fkey(row0[m * 64 + lane]) : 0u; u1[m] = (m < nm) ? fkey(row1[m * 64 + lane]) : 0u; }
    unsigned p0 = 0u, p1 = 0u; bool e0 = false, e1 = false;
    for (int bit = 31; bit >= 0; --bit) {
        const unsigned c0 = p0 | (1u << bit), c1 = p1 | (1u << bit);
        unsigned n0 = 0u, n1 = 0u;
#define CNT4(n, c, a0_, a1_, a2_, a3_) asm("v_cmp_le_u32_e64 s[20:21], %1, %2\n\tv_cmp_le_u32_e64 s[22:23], %1, %3\n\tv_cmp_le_u32_e64 s[24:25], %1, %4\n\tv_cmp_le_u32_e64 s[26:27], %1, %5\n\t" \
            "v_addc_co_u32_e64 %0, vcc, 0, %0, s[20:21]\n\tv_addc_co_u32_e64 %0, vcc, 0, %0, s[22:23]\n\tv_addc_co_u32_e64 %0, vcc, 0, %0, s[24:25]\n\tv_addc_co_u32_e64 %0, vcc, 0, %0, s[26:27]" \
            : "+v"(n) : "s"(c), "v"(a0_), "v"(a1_), "v"(a2_), "v"(a3_) : "s20", "s21", "s22", "s23", "s24", "s25", "s26", "s27", "vcc")
        const unsigned cs0 = (unsigned)__builtin_amdgcn_readfirstlane((int)c0), cs1 = (unsigned)__builtin_amdgcn_readfirstlane((int)c1);
#pragma unroll
        for (int m = 0; m < NMX; m += 4) { CNT4(n0, cs0, u0[m], u0[m + 1], u0[m + 2], u0[m + 3]); CNT4(n1, cs1, u1[m], u1[m + 1], u1[m + 2], u1[m + 3]); }
#undef CNT4
        const unsigned tot = wave_sum_u32(n0 | (n1 << 16));
        const unsigned t0 = tot & 0xffffu, t1 = tot >> 16;
        if (!e0) { if (t0 >= 256u) p0 = c0; if (t0 == 256u) e0 = true; }
        if (!e1) { if (t1 >= 256u) p1 = c1; if (t1 == 256u) e1 = true; }
        if (e0 && e1) break;
    }
    if (e0) { w0 = 0ull;
#pragma unroll
        for (int m = 0; m < NMX; ++m) { const unsigned long long bm = __ballot(u0[m] >= p0); w0 = (lane == m) ? bm : w0; }
    } else w0 = sel_ties<NMX>(u0, p0, lane);
    if (e1) { w1 = 0ull;
#pragma unroll
        for (int m = 0; m < NMX; ++m) { const unsigned long long bm = __ballot(u1[m] >= p1); w1 = (lane == m) ? bm : w1; }
    } else w1 = sel_ties<NMX>(u1, p1, lane);
}
struct SelRegs { bf16x8 qf[8][2]; bf16x8 wv; bf16x8 a0[4], a1[4]; };
#define SEL_LOADK(A0, A1, trip) do { _Pragma("unroll") for (int u = 0; u < 4; ++u) { const int kt = w + 32 * (trip) + 8 * u; const int ktc = kt < ntile ? kt : w; \
        const bf16* krow = h + (size_t)(b * S + ktc * 16 + fr) * LDH + H_BIK + fq * 8; A0[u] = *(const bf16x8*)krow; A1[u] = *(const bf16x8*)(krow + 32); } } while (0)
DI void sel_load(SelRegs& R, const bf16* h, int b, int qg, int w, int fr, int fq) {
    const int s0 = qg * 16, t0 = b * S + s0, ntile = ((s0 >> 6) + 1) * 4;
    const bf16* qrow = h + (size_t)(t0 + fr) * LDH;
#pragma unroll
    for (int hd = 0; hd < 8; ++hd)
#pragma unroll
        for (int ks = 0; ks < 2; ++ks) R.qf[hd][ks] = *(const bf16x8*)(qrow + H_BIQ + hd * 64 + ks * 32 + fq * 8);
    R.wv = *(const bf16x8*)(qrow + H_BIW);
    SEL_LOADK(R.a0, R.a1, 0);
}
DI void sel_scores(SelRegs& R, const bf16* h, int b, int qg, LAS float* sc, int w, int fr, int fq) {
    const int s0 = qg * 16, ntile = ((s0 >> 6) + 1) * 4, ntrip = (ntile + 31) >> 5;
    float wgt[8];
#pragma unroll
    for (int hd = 0; hd < 8; ++hd) wgt[hd] = (float)R.wv[hd] * C_IW;
#define SEL_COMPUTE(A0, A1, trip) do { _Pragma("unroll") for (int u = 0; u < 4; ++u) { const int kt = w + 32 * (trip) + 8 * u; \
        if (kt < ntile) { float s4[4] = {0.f, 0.f, 0.f, 0.f}; \
            _Pragma("unroll") for (int hd = 0; hd < 8; ++hd) { f32x4 a = {0.f, 0.f, 0.f, 0.f}; a = MFMA16(A0[u], R.qf[hd][0], a); a = MFMA16(A1[u], R.qf[hd][1], a); \
                _Pragma("unroll") for (int r = 0; r < 4; ++r) { const float rl = relu_i(a[r]); asm("v_fma_f32 %0, %1, %2, %0" : "+v"(s4[r]) : "v"(wgt[hd]), "v"(rl)); } } \
            *(LAS f32x4*)(sc + fr * SCLD + kt * 16 + fq * 4) = (f32x4){s4[0], s4[1], s4[2], s4[3]}; } } } while (0)
    bf16x8 b0[4], b1[4];
    for (int tp = 0; tp < ntrip; tp += 2) {
        SEL_LOADK(b0, b1, tp + 1);
        SEL_COMPUTE(R.a0, R.a1, tp);
        if (tp + 1 >= ntrip) break;
        SEL_LOADK(R.a0, R.a1, tp + 2);
        SEL_COMPUTE(b0, b1, tp + 1);
    }
#undef SEL_COMPUTE
}
#undef SEL_LOADK
DI void sel_select(unsigned* mask, int b, int qg, LAS float* sc, int w, int lane) {
    const int s0 = qg * 16, t0 = b * S + s0, nm = (s0 >> 6) + 1;
    const int q = 2 * w;
    unsigned long long w0 = ~0ull, w1 = ~0ull;
    if (nm <= 4) { }
    else if (nm <= 8) sel_rows2<8>(sc + q * SCLD, sc + (q + 1) * SCLD, nm, lane, w0, w1);
    else if (nm <= 16) sel_rows2<16>(sc + q * SCLD, sc + (q + 1) * SCLD, nm, lane, w0, w1);
    else if (nm <= 24) sel_rows2<24>(sc + q * SCLD, sc + (q + 1) * SCLD, nm, lane, w0, w1);
    else sel_rows2<32>(sc + q * SCLD, sc + (q + 1) * SCLD, nm, lane, w0, w1);
    if (lane < nm) { *(unsigned long long*)(mask + (size_t)(t0 + q) * 64 + 2 * lane) = w0; *(unsigned long long*)(mask + (size_t)(t0 + q + 1) * 64 + 2 * lane) = w1; }
}

DI void norm8(float (&x)[8], const float (&gain)[8], float scale) {
    float ss = 0.f;
#pragma unroll
    for (int j = 0; j < 8; ++j) ss += x[j] * x[j];
    ss = sum8(ss);
    const float rstd = frsq(ss * (1.f / 64.f) + EPS) * scale;
#pragma unroll
    for (int j = 0; j < 8; ++j) x[j] = x[j] * rstd * gain[j];
}
struct P1Gains { float bq[8], dq[8], dk[8], bk[8], kr[8]; float* sk; };
template <int NR>
DI void post1_rows(const Params& p, const P1Gains& g, const int (&t)[NR], int lane) {
    bf16x8 vdk[NR], vk[NR], vkr[NR]; f32x4 kcs[NR][2], ksn[NR][2];
#pragma unroll
    for (int i = 0; i < NR; ++i) {
        const bf16* hrow = (const bf16*)(p.ws + OFF_H) + (size_t)t[i] * LDH;
        vdk[i] = *(const bf16x8*)(hrow + H_DK + lane * 8);
        vk[i] = *(const bf16x8*)(hrow + H_BK + (lane & 7) * 8);
        vkr[i] = *(const bf16x8*)(hrow + H_CKR + (lane & 7) * 8);
        { const float* ct = (const float*)(p.ws + OFF_COS) + (size_t)(t[i] & (S - 1)) * 32 + (lane & 3) * 8; const float* sn = (const float*)(p.ws + OFF_SIN) + (size_t)(t[i] & (S - 1)) * 32 + (lane & 3) * 8;
          kcs[i][0] = *(const f32x4*)ct; kcs[i][1] = *(const f32x4*)(ct + 4); ksn[i][0] = *(const f32x4*)sn; ksn[i][1] = *(const f32x4*)(sn + 4); }
    }
#pragma unroll
    for (int i = 0; i < NR; ++i) {
        bf16* hrow = (bf16*)(p.ws + OFF_H) + (size_t)t[i] * LDH;
        float x[8];
#pragma unroll
        for (int j = 0; j < 8; ++j) x[j] = (float)vdk[i][j];
        norm8(x, g.dk, 1.f); *(bf16x8*)(hrow + H_DK + lane * 8) = cvt8(x);
#pragma unroll
        for (int j = 0; j < 8; ++j) x[j] = (float)vk[i][j];
        norm8(x, g.bk, 1.f); if (lane < 8) *(bf16x8*)(hrow + H_BK + lane * 8) = cvt8(x);
        { float ss = 0.f, xg[8], o8[8];
#pragma unroll
          for (int j = 0; j < 8; ++j) { const float xr = (float)vkr[i][j]; ss += xr * xr; xg[j] = xr * g.kr[j]; }
          ss = sum8(ss);
#pragma unroll
          for (int j = 0; j < 8; ++j) { const float ot = dpp_xor4(xg[j]), cs = kcs[i][j >> 2][j & 3], si = ksn[i][j >> 2][j & 3];
              o8[j] = (lane & 4) ? ot * si + xg[j] * cs : xg[j] * cs - ot * si; }
          if (lane < 32) *(bf16x8*)((bf16*)(p.ws + OFF_KC) + (size_t)t[i] * 768 + (lane >> 3) * 192 + 128 + (lane & 7) * 8) = cvt8(o8);
          if (lane < 4) __hip_atomic_fetch_add(g.sk + (size_t)t[i] * 4 + lane, ss, __ATOMIC_RELAXED, __HIP_MEMORY_SCOPE_AGENT); }
    }
}

struct AttnWave { const bf16* Q; int ldq; const bf16* Z; bf16* Y; int s0, kbeg, kend; int hd; };
template <int DK, int DV> struct AttnCfg {
    static constexpr int KST = DK * 2 + 16, VST = 144;
    static constexpr int KBYTES = 64 * KST, VBYTES = DV * VST, RKB = (DK == 192) ? 256 : 0, STG = KBYTES + VBYTES + RKB;
    static constexpr int CPR = DK / 8, NKL = (64 * CPR) / 512, NVL = (DV * 8) / 512;
    static constexpr int TAB_OFF = 2 * STG, MSK_OFF = TAB_OFF + 8 * 256 * 4, MSK_LD = 65;
};
template <int DK, int DV, int MODE>
DI void attn_stage(LAS unsigned char* kb, const int k0, const AttnWave& aw, const bf16x8 (&qf)[DK / 16], f32x16 (&o)[DV / 32], float& m_run, float& l0, float& l1, f32x16& bmv,
                   const float bfar, const LAS float* wtab, const LAS unsigned* lmsk, const int r, const int hh, const int pr) {
    typedef AttnCfg<DK, DV> C;
    constexpr int J = (DK == 64) ? 2 : 1;
    LAS unsigned char* vb = kb + C::KBYTES;
    if (!(k0 >= aw.kbeg && k0 < aw.kend)) return;
#pragma unroll
    for (int g0 = 0; g0 < 2; g0 += J) {
        const bool first = (k0 + 32 * g0 == aw.kbeg);
        f32x16 st[J];
        constexpr int NKF = DK / 16 < 8 ? DK / 16 : 8;
        bf16x8 kf[J][NKF];
#pragma unroll
        for (int j = 0; j < J; ++j) {
            if (MODE == 0) {
#pragma unroll
                for (int i = 0; i < 16; ++i) st[j][i] = 0.f;
            }
#pragma unroll
            for (int s = 0; s < NKF; ++s) kf[j][s] = *(const LAS bf16x8*)(kb + (32 * (g0 + j) + pr) * C::KST + 16 * hh + 32 * s);
        }
        f32x4 rk0, rk1, rk2, rk3;
        if (MODE == 0) { const LAS float* rkp = (const LAS float*)(vb + C::VBYTES) + 32 * g0 + 8 * hh;
            rk0 = *(const LAS f32x4*)rkp; rk1 = *(const LAS f32x4*)(rkp + 4); rk2 = *(const LAS f32x4*)(rkp + 16); rk3 = *(const LAS f32x4*)(rkp + 20); }
        __builtin_amdgcn_sched_barrier(0);
#pragma unroll
        for (int s = 0; s < DK / 16; ++s)
#pragma unroll
            for (int j = 0; j < J; ++j) {
                if (MODE != 0 && s == 0) {
                    const int kk0 = k0 + 32 * (g0 + j);
                    if (kk0 + 31 + 128 <= aw.s0) st[j] = MFMA32(kf[j][0], qf[0], bmv);
                    else {
                        const int base = kk0 + 8 * hh - (aw.s0 + r);
                        float ci[16];
#pragma unroll
                        for (int i = 0; i < 16; ++i) { const float wt = wtab[base + 16 * (i >> 3) + (i & 7) + 192];
                            asm("v_sub_f32 %0, %1, %2" : "=v"(ci[i]) : "v"(wt), "v"(m_run)); }
                        f32x16 cv;
#pragma unroll
                        for (int i = 0; i < 16; ++i) cv[i] = ci[i];
                        st[j] = MFMA32(kf[j][0], qf[0], cv);
                    }
                } else st[j] = MFMA32(kf[j][s % NKF], qf[s], st[j]);
                if (s + NKF < DK / 16) kf[j][s % NKF] = *(const LAS bf16x8*)(kb + (32 * (g0 + j) + pr) * C::KST + 16 * hh + 32 * (s + NKF)); }
        bf16x8 vf[J][DV / 32][2];
#pragma unroll
        for (int j = 0; j < J; ++j)
#pragma unroll
            for (int d = 0; d < DV / 32; ++d)
#pragma unroll
                for (int s2 = 0; s2 < 2; ++s2) vf[j][d][s2] = *(const LAS bf16x8*)(vb + (32 * d + r) * C::VST + (32 * (g0 + j) + 16 * s2 + 8 * hh) * 2);
        __builtin_amdgcn_sched_barrier(0);
        if (MODE == 0) {
#pragma unroll
            for (int i = 0; i < 4; ++i) { st[0][i] = __builtin_fmaf(st[0][i], rk0[i], -m_run); st[0][4 + i] = __builtin_fmaf(st[0][4 + i], rk1[i], -m_run);
                st[0][8 + i] = __builtin_fmaf(st[0][8 + i], rk2[i], -m_run); st[0][12 + i] = __builtin_fmaf(st[0][12 + i], rk3[i], -m_run); }
        }
        float mx = fmaxf(fmaxf(st[0][0], st[0][1]), st[0][2]);
#pragma unroll
        for (int i = 3; i < 15; i += 2) mx = fmaxf(fmaxf(mx, st[0][i]), st[0][i + 1]);
        mx = fmaxf(mx, st[0][15]);
        if (J == 2) {
#pragma unroll
            for (int i = 0; i < 16; i += 2) mx = fmaxf(fmaxf(mx, st[J - 1][i]), st[J - 1][i + 1]);
        }
        mx = xhalf_max(mx);
        if (first || !__all(mx <= 8.f)) {
            const float d = first ? mx : fmaxf(mx, 0.f), alpha = fexp2(-d);
            m_run += d; l0 *= alpha; l1 *= alpha;
            if (MODE != 0) { const float bm = bfar - m_run;
#pragma unroll
                for (int i = 0; i < 16; ++i) bmv[i] = bm; }
#pragma unroll
            for (int dd = 0; dd < DV / 32; ++dd)
#pragma unroll
                for (int i = 0; i < 16; ++i) o[dd][i] *= alpha;
#pragma unroll
            for (int j = 0; j < J; ++j)
#pragma unroll
                for (int i = 0; i < 16; ++i) st[j][i] -= d;
        }
#pragma unroll
        for (int j = 0; j < J; ++j) {
            float pv[16];
            if (MODE == 1) {
#pragma unroll
                for (int i = 0; i < 16; ++i) pv[i] = fexp2(st[j][i]);
                __builtin_amdgcn_sched_barrier(0);
                const unsigned mw = lmsk[r * C::MSK_LD + ((k0 + 32 * (g0 + j)) >> 5)] >> (8 * hh);
#define MASK_AND(i) asm("v_bfe_i32 %0, %1, %2, 1\n\tv_and_b32 %0, %0, %3" : "=&v"(pv[i]) : "v"(mw), "n"(16 * ((i) >> 3) + ((i) & 7)), "v"(pv[i]))
                MASK_AND(0); MASK_AND(1); MASK_AND(2); MASK_AND(3); MASK_AND(4); MASK_AND(5); MASK_AND(6); MASK_AND(7);
                MASK_AND(8); MASK_AND(9); MASK_AND(10); MASK_AND(11); MASK_AND(12); MASK_AND(13); MASK_AND(14); MASK_AND(15);
#undef MASK_AND
#pragma unroll
                for (int i = 0; i < 8; ++i) { asm volatile("v_add_f32 %0, %0, %1" : "+v"(l0) : "v"(pv[2 * i])); asm volatile("v_add_f32 %0, %0, %1" : "+v"(l1) : "v"(pv[2 * i + 1])); }
            } else {
#pragma unroll
                for (int i = 0; i < 8; ++i) pv[i] = fexp2(st[j][i]);
                __builtin_amdgcn_sched_barrier(0); asm volatile("s_nop 0");
#pragma unroll
                for (int i = 0; i < 4; ++i) { asm volatile("v_add_f32 %0, %0, %1" : "+v"(l0) : "v"(pv[2 * i])); asm volatile("v_add_f32 %0, %0, %1" : "+v"(l1) : "v"(pv[2 * i + 1])); }
#pragma unroll
                for (int i = 8; i < 16; ++i) pv[i] = fexp2(st[j][i]);
                __builtin_amdgcn_sched_barrier(0); asm volatile("s_nop 0");
#pragma unroll
                for (int i = 4; i < 8; ++i) { asm volatile("v_add_f32 %0, %0, %1" : "+v"(l0) : "v"(pv[2 * i])); asm volatile("v_add_f32 %0, %0, %1" : "+v"(l1) : "v"(pv[2 * i + 1])); }
            }
            bf16x8 pf[2];
#pragma unroll
            for (int s2 = 0; s2 < 2; ++s2) { f32x8 t8;
#pragma unroll
                for (int jj = 0; jj < 8; ++jj) t8[jj] = pv[8 * s2 + jj];
                pf[s2] = __builtin_convertvector(t8, bf16x8); }
#pragma unroll
            for (int d = 0; d < DV / 32; ++d)
#pragma unroll
                for (int s2 = 0; s2 < 2; ++s2) o[d] = MFMA32(vf[j][d][s2], pf[s2], o[d]);
        }
    }
}
template <int DK, int DV, int MODE>
DI void attn_block(LAS unsigned char* lds, const bf16* Kg, int ldk, const bf16* VTg, int kb0, int kb1, const AttnWave aw, const float* gtab, const unsigned* gmask, int tid, const Params& p, int l, int b) {
    typedef AttnCfg<DK, DV> C;
    constexpr int NKL = C::NKL, NVL = C::NVL, STG = C::STG;
    static_assert(C::MSK_OFF + 32 * C::MSK_LD * 4 <= LDS_MISC, "attention LDS exceeds budget");
    const int lane = tid & 63, r = lane & 31, hh = lane >> 5;
    const int pr = (r & 0x13) | ((r & 8) >> 1) | ((r & 4) << 1);
    LAS float* ltab = (LAS float*)(lds + C::TAB_OFF); LAS unsigned* lmsk = (LAS unsigned*)(lds + C::MSK_OFF);
    if (MODE == 1) {
#pragma unroll
        for (int e = tid; e < 2048; e += 512) { const int hd = e >> 8, i = e & 255; ltab[e] = gtab[hd * 2112 + i - 192 + 2047]; }
#pragma unroll
        for (int e = tid; e < 2048; e += 512) { const int q = e >> 6, wd = e & 63; lmsk[q * C::MSK_LD + wd] = gmask[(size_t)q * 64 + wd]; }
    } else if (MODE == 2) {
        if (tid < 256) { int d = 192 - tid; d = d < -128 ? -128 : (d > 128 ? 128 : d); ltab[tid] = gtab[d + 128]; }
    }
    bf16x8 qf[DK / 16];
#pragma unroll
    for (int s = 0; s < DK / 16; ++s) qf[s] = *(const bf16x8*)(aw.Q + (size_t)r * aw.ldq + 16 * s + 8 * hh);
    const float* kstat = (const float*)(p.ws + OFF_STATK) + (size_t)l * T * 4 + (size_t)b * S * 4 + aw.hd;
    if constexpr (MODE != 0) {
        const float* gq_ = (MODE == 1 ? p.b_q_gain : p.d_q_gain) + l * 64;
        float ssq = 0.f;
#pragma unroll
        for (int s = 0; s < 4; ++s)
#pragma unroll
            for (int j = 0; j < 8; ++j) { const float x = (float)qf[s][j]; ssq += x * x; }
        ssq = xhalf_sum(ssq);
        const float rq = frsq(ssq * (1.f / 64.f) + EPS) * SCALE_64;
#pragma unroll
        for (int s = 0; s < 4; ++s) { const f32x4 ga = *(const f32x4*)(gq_ + 16 * s + 8 * hh), gb = *(const f32x4*)(gq_ + 16 * s + 8 * hh + 4); float x[8];
#pragma unroll
            for (int j = 0; j < 4; ++j) { x[j] = (float)qf[s][j] * rq * ga[j]; x[4 + j] = (float)qf[s][4 + j] * rq * gb[j]; }
            qf[s] = cvt8(x); }
    }
    if constexpr (MODE == 0) {
        const size_t tq_ = (size_t)b * S + aw.s0 + r;
        const float rq = frsq(((const float*)(p.ws + OFF_STATQ))[(size_t)l * T * 4 + tq_ * 4 + aw.hd] * (1.f / 192.f) + EPS) * SCALE_192;
#pragma unroll
        for (int s = 0; s < 8; ++s) { float x[8];
#pragma unroll
            for (int j = 0; j < 8; ++j) x[j] = (float)qf[s][j] * rq;
            qf[s] = cvt8(x); }
        const float* cs_ = (const float*)(p.ws + OFF_COS) + (size_t)(aw.s0 + r) * 32; const float* sn_ = (const float*)(p.ws + OFF_SIN) + (size_t)(aw.s0 + r) * 32;
#pragma unroll
        for (int s = 8; s < 10; ++s) {
            const int i0 = 16 * (s - 8) + 8 * hh;
            const f32x4 ca = *(const f32x4*)(cs_ + i0), cb = *(const f32x4*)(cs_ + i0 + 4), sa = *(const f32x4*)(sn_ + i0), sb = *(const f32x4*)(sn_ + i0 + 4);
            float xa[8], xb[8];
#pragma unroll
            for (int j = 0; j < 8; ++j) { const float a = (float)qf[s][j] * rq, bq = (float)qf[s + 2][j] * rq;
                const float c = j < 4 ? ca[j & 3] : cb[j & 3], sv = j < 4 ? sa[j & 3] : sb[j & 3];
                xa[j] = a * c - bq * sv; xb[j] = bq * c + a * sv; }
            qf[s] = cvt8(xa); qf[s + 2] = cvt8(xb);
        }
    }
    f32x16 o[DV / 32];
#pragma unroll
    for (int d = 0; d < DV / 32; ++d)
#pragma unroll
        for (int i = 0; i < 16; ++i) o[d][i] = 0.f;
    float m_run = 0.f, l0 = 0.f, l1 = 0.f;
    const float bfar = (MODE == 1) ? gtab[aw.hd * 2112] : (MODE == 2 ? gtab[256] : 0.f);
    const LAS float* wtab = ltab + (MODE == 1 ? aw.hd * 256 : 0);
    f32x16 bmv;
#pragma unroll
    for (int i = 0; i < 16; ++i) bmv[i] = bfar;
    unsigned kgo[NKL], vgo[NVL]; int kl[NKL], vl[NVL];
#pragma unroll
    for (int i = 0; i < NKL; ++i) { const int c = tid + 512 * i, row = c / C::CPR, ch = c % C::CPR; kgo[i] = (unsigned)(row * ldk + ch * 8) * 2u; kl[i] = row * C::KST + ch * 16; }
#pragma unroll
    for (int i = 0; i < NVL; ++i) { const int c = tid + 512 * i, d = c >> 3, ch = c & 7; vgo[i] = (unsigned)(d * T + ch * 8) * 2u; vl[i] = C::KBYTES + d * C::VST + ch * 16; }
    u32x4 krA[NKL], vrA[NVL]; float skA = 0.f;
#define AT_LOAD(KR, VR, kk) do { const char* kbase_ = (const char*)(Kg + (size_t)(kk) * ldk); const char* vbase_ = (const char*)(VTg + (kk)); \
        _Pragma("unroll") for (int i = 0; i < NKL; ++i) KR[i] = *(const u32x4*)(kbase_ + kgo[i]); \
        _Pragma("unroll") for (int i = 0; i < NVL; ++i) VR[i] = *(const u32x4*)(vbase_ + vgo[i]); \
        if (MODE == 0 && tid < 64) skA = kstat[(size_t)((kk) + tid) * 4]; } while (0)
#define AT_WRITE(KR, VR, boff) do { \
        _Pragma("unroll") for (int i = 0; i < NKL; ++i) *(LAS u32x4*)(lds + (boff) + kl[i]) = KR[i]; \
        _Pragma("unroll") for (int i = 0; i < NVL; ++i) *(LAS u32x4*)(lds + (boff) + vl[i]) = VR[i]; \
        if (MODE == 0 && tid < 64) *(LAS float*)(lds + (boff) + C::KBYTES + C::VBYTES + tid * 4) = frsq(skA * (1.f / 192.f) + EPS); } while (0)
    const int klast = kb1 - 64;
    AT_LOAD(krA, vrA, kb0);
    AT_WRITE(krA, vrA, 0);
#pragma unroll
    for (int s = 0; s < DK / 16; ++s) asm volatile("" :: "v"(qf[s]));
    asm volatile("" :: "v"(bfar));
    __syncthreads();
    int cur = 0;
    for (int k0 = kb0; k0 < kb1; k0 += 64) {
        AT_LOAD(krA, vrA, (k0 + 64 < klast ? k0 + 64 : klast));
        attn_stage<DK, DV, MODE>(lds + cur * STG, k0, aw, qf, o, m_run, l0, l1, bmv, bfar, wtab, lmsk, r, hh, pr);
        AT_WRITE(krA, vrA, (cur ^ 1) * STG);
        __syncthreads();
        cur ^= 1;
    }
#undef AT_LOAD
#undef AT_WRITE
    const float lt = xhalf_sum(l0 + l1), inv = frcp(lt);
    bf16x4 zv[DV / 32][4];
#pragma unroll
    for (int d = 0; d < DV / 32; ++d)
#pragma unroll
        for (int g = 0; g < 4; ++g) zv[d][g] = *(const bf16x4*)(aw.Z + (size_t)r * LDH + 32 * d + 8 * g + 4 * hh);
#pragma unroll
    for (int d = 0; d < DV / 32; ++d)
#pragma unroll
        for (int g = 0; g < 4; ++g) {
            const int dd = 32 * d + 8 * g + 4 * hh;
            f32x4 ov;
#pragma unroll
            for (int e = 0; e < 4; ++e) ov[e] = o[d][4 * g + e] * inv * silu_f((float)zv[d][g][e]);
            *(bf16x4*)(aw.Y + (size_t)r * DM + dd) = __builtin_convertvector(ov, bf16x4);
        }
}

DI void avnorm_item(const Params& p, int item, LAS float* ls, int tid) {
    const int tb = item * 128, c = tid & 15, frow = tid >> 4, w = tid >> 6;
    const bf16* src = (const bf16*)(p.ws + OFF_VT) + (size_t)(VT_AV + frow) * T + tb + c * 8;
    float acc[8];
#pragma unroll
    for (int j = 0; j < 8; ++j) acc[j] = 0.f;
#pragma unroll
    for (int i = 0; i < 16; ++i) { const bf16x8 v = *(const bf16x8*)(src + (size_t)(32 * i) * T);
#pragma unroll
        for (int j = 0; j < 8; ++j) { const float f = (float)v[j]; acc[j] += f * f; } }
#pragma unroll
    for (int j = 0; j < 8; ++j) { acc[j] = xrow_sum(acc[j]); acc[j] = xhalf_sum(acc[j]); }
    if ((tid & 63) < 16) {
#pragma unroll
        for (int j = 0; j < 8; ++j) ls[w * 128 + c * 8 + j] = acc[j];
    }
    __syncthreads();
    if (tid < 128) { float sum = 0.f;
#pragma unroll
        for (int k = 0; k < 8; ++k) sum += ls[k * 128 + tid];
        ((float*)(p.ws + OFF_SSV))[tb + tid] = frsq(sum * (1.f / 512.f) + EPS); }
    __syncthreads();
}
DI void mixA_item(const Params& p, int l, int item, int tid) {
    const int w = __builtin_amdgcn_readfirstlane(tid >> 6), lane = tid & 63, r = lane & 31, hh = lane >> 5;
    const int g = item & 3, n = (item >> 2) & 15, b = item >> 6, tb = b * S + n * 128;
    const int it = w >> 1, cp = w & 1;
    const bf16* Wa = (const bf16*)(p.ws + OFF_WA) + (size_t)(l * 4 + g) * 128 * 128;
    const bf16* gvT = (const bf16*)(p.ws + OFF_VT); const float* rstd = (const float*)(p.ws + OFF_SSV) + tb;
    const bf16* hb = (const bf16*)(p.ws + OFF_H); bf16* y = (bf16*)(p.ws + OFF_U3);
    f32x16 acc[2];
#pragma unroll
    for (int c = 0; c < 2; ++c)
#pragma unroll
        for (int i = 0; i < 16; ++i) acc[c][i] = 0.f;
    bf16x8 wf[8], raw[2][8]; f32x4 rs0[8], rs1[8]; float gn[2];
#pragma unroll
    for (int ci = 0; ci < 2; ++ci) gn[ci] = p.a_v_gain[l * 512 + g * 128 + (2 * cp + ci) * 32 + r];
#pragma unroll
    for (int s = 0; s < 8; ++s) {
        wf[s] = *(const bf16x8*)(Wa + (size_t)(it * 32 + r) * 128 + s * 16 + hh * 8);
        rs0[s] = *(const f32x4*)(rstd + s * 16 + hh * 8); rs1[s] = *(const f32x4*)(rstd + s * 16 + hh * 8 + 4);
#pragma unroll
        for (int ci = 0; ci < 2; ++ci) raw[ci][s] = *(const bf16x8*)(gvT + (size_t)(VT_AV + g * 128 + (2 * cp + ci) * 32 + r) * T + tb + s * 16 + hh * 8);
    }
#pragma unroll
    for (int s = 0; s < 8; ++s) {
        if (s < 4 || it >= 2) {
#pragma unroll
            for (int ci = 0; ci < 2; ++ci) {
                float bv[8];
#pragma unroll
                for (int j = 0; j < 4; ++j) { bv[j] = (float)raw[ci][s][j] * rs0[s][j] * gn[ci]; bv[4 + j] = (float)raw[ci][s][4 + j] * rs1[s][j] * gn[ci]; }
                acc[ci] = MFMA32(cvt8(bv), wf[s], acc[ci]);
            }
        }
    }
    const size_t t = (size_t)tb + it * 32 + r;
    const float bs = p.a_bs[(size_t)(l * 4 + g) * 128 + it * 32 + r];
    bf16x4 uv[2][4], zv[2][4];
#pragma unroll
    for (int ci = 0; ci < 2; ++ci)
#pragma unroll
        for (int g4 = 0; g4 < 4; ++g4) { const int col = g * 128 + (2 * cp + ci) * 32 + 8 * g4 + 4 * hh;
            uv[ci][g4] = *(const bf16x4*)(hb + t * LDH + H_AU + col); zv[ci][g4] = *(const bf16x4*)(hb + t * LDH + H_AZ + col); }
#pragma unroll
    for (int ci = 0; ci < 2; ++ci)
#pragma unroll
        for (int g4 = 0; g4 < 4; ++g4) {
            const int col = g * 128 + (2 * cp + ci) * 32 + 8 * g4 + 4 * hh;
            f32x4 ov;
#pragma unroll
            for (int e = 0; e < 4; ++e) ov[e] = gelu_t((float)uv[ci][g4][e]) * (acc[ci][4 * g4 + e] + bs) * silu_f((float)zv[ci][g4][e]);
            *(bf16x4*)(y + t * DM + col) = __builtin_convertvector(ov, bf16x4);
        }
}

DI void phase_mix(const Params& p, int l, int G, LAS unsigned char* lds, int wv) {
    const int tid = opaque_tid(wv), w = __builtin_amdgcn_readfirstlane(tid >> 6);
    const bf16* hb = (const bf16*)(p.ws + OFF_H); bf16* y = (bf16*)(p.ws + OFF_U3);
    const bf16* vT = (const bf16*)(p.ws + OFF_VT);
    unsigned* ctr = (unsigned*)(p.ws + OFF_CTL) + XB_CTR(l);
    volatile LAS unsigned* bc = (volatile LAS unsigned*)(lds + LDS_MISC) + 4;
    for (;;) {
        if (tid == 0) *bc = xb_add(ctr, 1u);
        __syncthreads();
        const int item = (int)*bc;
        __syncthreads();
        if (item >= 1792) break;
        int tq = tid; asm volatile("" : "+v"(tq));
        if (item < 256) {
            const int qb = 7 - (item >> 5), bh = item & 31, b = bh >> 2, hd = bh & 3, s0 = qb * 256 + 32 * w; const size_t t0 = (size_t)b * S + s0;
            AttnWave aw{(const bf16*)(p.ws + OFF_QC) + t0 * 768 + hd * 192, 768, hb + t0 * LDH + H_CZ + hd * 128, y + t0 * DM + 1024 + hd * 128, s0, 0, ((s0 >> 6) + 1) * 64, hd};
            attn_block<192, 128, 0>(lds, (const bf16*)(p.ws + OFF_KC) + (size_t)b * S * 768 + hd * 192, 768, (const bf16*)(p.ws + OFF_VCT) + (size_t)(hd * 128) * T + (size_t)b * S,
                                    0, (qb + 1) * 256, aw, nullptr, nullptr, tq, p, l, b);
        } else if (item < 768) {
            const int j = item - 256, qt = 63 - (j >> 3), b = j & 7, s0 = qt * 32, hd = w; const size_t t0 = (size_t)b * S + s0;
            AttnWave aw{hb + t0 * LDH + H_BQ + hd * 64, LDH, hb + t0 * LDH + H_BZ + hd * 64, y + t0 * DM + 512 + hd * 64, s0, 0, ((s0 >> 6) + 1) * 64, hd};
            attn_block<64, 64, 1>(lds, hb + (size_t)b * S * LDH + H_BK, LDH, vT + (size_t)VT_BV * T + (size_t)b * S, 0, ((s0 >> 6) + 1) * 64, aw,
                                  (const float*)(p.ws + OFF_T5), (const unsigned*)(p.ws + OFF_MASK) + t0 * 64, tq, p, l, b);
        } else if (item < 1280) {
            const int j = item - 768, qb = 7 - (j >> 6), bh = j & 63, b = bh >> 3, hd = bh & 7, s0 = qb * 256 + 32 * w, c = s0 >> 6; const size_t t0 = (size_t)b * S + s0;
            AttnWave aw{hb + t0 * LDH + H_DQ + hd * 64, LDH, hb + t0 * LDH + H_DZ + hd * 64, y + t0 * DM + 1536 + hd * 64, s0, (c > 8 ? c - 8 : 0) * 64, (c + 1) * 64, hd};
            const int c0 = qb * 4;
            attn_block<64, 64, 2>(lds, hb + (size_t)b * S * LDH + H_DK + hd * 64, LDH, vT + (size_t)(VT_DV + hd * 64) * T + (size_t)b * S, (c0 > 8 ? c0 - 8 : 0) * 64, (c0 + 4) * 64, aw,
                                  (const float*)(p.ws + OFF_DT) + (size_t)l * 8 * 264 + hd * 264, nullptr, tq, p, l, b);
        } else {
            mixA_item(p, l, item - 1280, tq);
        }
    }
}

DI void phase_select_post1(const Params& p, int l, int G, LAS unsigned char* lds, int wv) {
    const int tid = opaque_tid(wv), blk = blockIdx.x, w = __builtin_amdgcn_readfirstlane(tid >> 6), lane = tid & 63;
    const bf16* hb = (const bf16*)(p.ws + OFF_H); unsigned* mask = (unsigned*)(p.ws + OFF_MASK);
    unsigned* ctr = (unsigned*)(p.ws + OFF_CTL) + XB_CTR(2 + l);
    volatile LAS unsigned* bc = (volatile LAS unsigned*)(lds + LDS_MISC) + 4;
    const int fr = lane & 15, fq = lane >> 4;
    SelRegs R;
    if (tid == 0) *bc = xb_add(ctr, 1u);
    __syncthreads();
    int j = (int)*bc;
    __syncthreads();
    if (j < 1024) sel_load(R, hb, j & 7, 127 - (j >> 3), w, fr, fq);
    while (j < 1024) {
        if (tid == 0) *bc = xb_add(ctr, 1u);
        {
            const int b = j & 7, qg = 127 - (j >> 3);
            if (qg >= 16) sel_scores(R, hb, b, qg, (LAS float*)lds, w, fr, fq);
            __syncthreads();
            const int jn = (int)*bc;
            if (jn < 1024) sel_load(R, hb, jn & 7, 127 - (jn >> 3), w, fr, fq);
            sel_select(mask, b, qg, (LAS float*)lds, w, lane);
            __syncthreads();
            j = jn;
        }
    }
    while (j < 1408) {
        if (tid == 0) *bc = xb_add(ctr, 1u);
        {
            if (j < 1152) avnorm_item(p, j - 1024, (LAS float*)lds, tid);
            else { const int r0 = (j - 1152) * 64 + w * 8;
                int lq = lane; asm volatile("" : "+v"(lq));
                P1Gains pg; pg.sk = (float*)(p.ws + OFF_STATK) + (size_t)l * T * 4; { const int d0 = (lq & 7) * 8;
#pragma unroll
        for (int j = 0; j < 8; ++j) { pg.bq[j] = p.b_q_gain[l * 64 + d0 + j]; pg.dq[j] = p.d_q_gain[l * 64 + d0 + j]; pg.dk[j] = p.d_k_gain[l * 64 + d0 + j]; pg.bk[j] = p.b_k_gain[l * 64 + d0 + j]; pg.kr[j] = p.c_k_gain[l * 192 + 128 + d0 + j]; } }
#pragma unroll 1
                for (int i = 0; i < 8; i += 4) { const int tt[4] = {r0 + i, r0 + i + 1, r0 + i + 2, r0 + i + 3}; post1_rows<4>(p, pg, tt, lq); } }
            __syncthreads();
            const int jn = (int)*bc;
            __syncthreads();
            j = jn;
        }
    }
}
__global__ void __launch_bounds__(512, 2) fwd_mega(Params p) {
    extern __shared__ __attribute__((aligned(16))) unsigned char lds_raw[];
    LAS unsigned char* lds = (LAS unsigned char*)lds_raw;
    cg::grid_group grid = cg::this_grid();
    const int G = gridDim.x, blk = blockIdx.x;
    const int wv = __builtin_amdgcn_readfirstlane(threadIdx.x >> 6);
    volatile LAS unsigned* misc = (volatile LAS unsigned*)(lds + LDS_MISC);
    if (threadIdx.x < 8) misc[threadIdx.x] = 0u;
    __syncthreads();
    XcdBarrier bar = xcd_barrier_post((unsigned*)(p.ws + OFF_CTL), misc, threadIdx.x == 0);
#define SEAM() xcd_barrier(bar, wv)
    phase_prep(p, lds, G, wv);
    if (G > (1 << 24)) grid.sync();
    SEAM();
#pragma unroll 1
    for (int l = 0; l < 2; ++l) {
        {
            Sched1 S1{blk, G, 64 + 26 * l, l == 0 ? 1664 : 1536};
            Epi1 E1{(bf16*)(p.ws + OFF_H), (bf16*)(p.ws + OFF_U2), (bf16*)(p.ws + OFF_VT), 64 + 26 * l, (float*)(p.ws + OFF_STATL) + (size_t)l * T * 2, (const float*)(p.ws + OFF_STATX) + (size_t)l * T};
            pg8::Gemm g1{(const pg8::bf16_t*)(p.ws + OFF_U1), (const pg8::bf16_t*)(p.ws + OFF_U1), 2048};
            pg8::gemm_phase<Epi1, Sched1, G_ALIGN, G_SP2>(lds, g1, S1, E1, wv);
            if (l == 1) { Sched1H S1h{blk, G, 64 + 26 * l}; pg8::gemm_phase<Epi1, Sched1H, G_ALIGN, G_SP2, true>(lds, g1, S1h, E1, wv); }
            if (l == 0) { int Gq = G; asm volatile("" : "+s"(Gq));
                const int nfull = 1664 % Gq, nidle = Gq - nfull;
                if (nfull > 0 && blk >= nfull) prep_weights(p, 1, (LAS float*)lds, blk - nfull, nidle, opaque_tid(wv));
                else if (nfull == 0) prep_weights(p, 1, (LAS float*)lds, blk, G, opaque_tid(wv)); }
        }
        SEAM();
        {
            Sched2 S2{blk, G, 64 + 7 * l};
            Epi2 E2{(bf16*)(p.ws + OFF_QC), (bf16*)(p.ws + OFF_KC), (bf16*)(p.ws + OFF_VCT), (const float*)(p.ws + OFF_STATL) + (size_t)l * T * 2, 64 + 7 * l, (float*)(p.ws + OFF_STATK) + (size_t)l * T * 4, (float*)(p.ws + OFF_STATQ) + (size_t)l * T * 4, p.c_q_gain + l * 192, p.c_k_gain + l * 192};
            pg8::Gemm g2{(const pg8::bf16_t*)(p.ws + OFF_U2), (const pg8::bf16_t*)(p.ws + OFF_U2), 512};
            pg8::gemm_phase<Epi2, Sched2, G_ALIGN, G_SP2>(lds, g2, S2, E2, wv);
        }
        phase_select_post1(p, l, G, lds, wv);
        SEAM();
        phase_mix(p, l, G, lds, wv);
        SEAM();
        {
            Sched3 S3{blk, G, 64 + 8 * l};
            pg8::Gemm g3{(const pg8::bf16_t*)(p.ws + OFF_U3), (const pg8::bf16_t*)(p.ws + OFF_U3), 2048};
            if (l == 0) { Epi3<true> E3{p.x, nullptr, nullptr, (bf16*)(p.ws + OFF_U1), (float*)(p.ws + OFF_STATX) + T, 64 + 8 * l};
                pg8::gemm_phase<Epi3<true>, Sched3, G_ALIGN, G_SP2>(lds, g3, S3, E3, wv); }
            else { Epi3<false> E3{nullptr, (const bf16*)(p.ws + OFF_U1), p.out, nullptr, nullptr, 64 + 8 * l};
                pg8::gemm_phase<Epi3<false>, Sched3, G_ALIGN, G_SP2>(lds, g3, S3, E3, wv); }
        }
        if (l == 0) SEAM();
    }
}

extern "C" void kernel_launch(void* const* d_in, const int* in_sizes, int n_in, void* d_out, int out_size, void* d_ws, size_t ws_size, hipStream_t stream) {
    static int grid_blocks = 0;
    if (!grid_blocks) {
        int dev = 0, cus = 0, per_cu = 0;
        hipGetDevice(&dev);
        hipDeviceGetAttribute(&cus, hipDeviceAttributeMultiprocessorCount, dev);
        hipFuncSetAttribute((const void*)fwd_mega, hipFuncAttributeMaxDynamicSharedMemorySize, (int)LDS_BYTES);
        hipOccupancyMaxActiveBlocksPerMultiprocessor(&per_cu, fwd_mega, 512, LDS_BYTES);
        if (per_cu > 1) per_cu = 1;
        grid_blocks = cus * per_cu;
        if (grid_blocks <= 0 || ws_size < WS_NEED) fprintf(stderr, "bad config: grid %d ws %zu need %zu\n", grid_blocks, ws_size, (size_t)WS_NEED);
    }
    Params p{};
    p.x = (const float*)d_in[0]; p.t5_bias = (const float*)d_in[1]; p.norm_g = (const float*)d_in[2]; p.w_in = (const float*)d_in[3];
    p.a_v_gain = (const float*)d_in[4]; p.a_ws = (const float*)d_in[5]; p.a_bs = (const float*)d_in[6]; p.b_q_gain = (const float*)d_in[7];
    p.b_k_gain = (const float*)d_in[8]; p.c_qa_gain = (const float*)d_in[9]; p.c_kva_gain = (const float*)d_in[10]; p.c_w_qb = (const float*)d_in[11];
    p.c_w_kvb = (const float*)d_in[12]; p.c_q_gain = (const float*)d_in[13]; p.c_k_gain = (const float*)d_in[14]; p.d_q_gain = (const float*)d_in[15];
    p.d_k_gain = (const float*)d_in[16]; p.d_rel_bias = (const float*)d_in[17]; p.w_out = (const float*)d_in[18];
    p.out = (float*)d_out; p.ws = (unsigned char*)d_ws;
    hipMemsetAsync((unsigned char*)d_ws + OFF_CTL, 0, CTL_BYTES, stream);
    void* args[] = {&p};
    hipError_t e = hipLaunchCooperativeKernel((void*)fwd_mega, dim3(grid_blocks), dim3(512), args, LDS_BYTES, stream);
    if (e != hipSuccess) fprintf(stderr, "cooperative launch failed: %s (grid %d)\n", hipGetErrorString(e), grid_blocks);
}
```
